# Optimizing an MI355X kernel written in HIP

```python
import jax, jax.numpy as jnp
from jax import lax
import numpy as np


D_MODEL = 1024
BATCH = 4
SEQ = 4096
DEPTH = 2
DEC_BATCH = 32
DEC_SEQ = 1
PAST_LEN = 8192
PAGE_SIZE = 128

N_EVEN = (DEPTH + 1) // 2
N_ODD = DEPTH // 2
EPS = 1e-6
W_A = D_MODEL
CONV_W = 3
H_B = 16
HD_B = 64
W_B = H_B * HD_B
DIL_PATTERNS = ((128, 1), (512, 4), (2048, 16))
MAX_WINDOW = 2048
POOL_SIZES = (2, 4, 8, 16)
N_POOL = 4
W_C = D_MODEL
G_C = W_C // N_POOL
POOL_MAX = 16
H_D = 4
DK_D = 256
DV_D = 256
W_D = H_D * DV_D
RET_CHUNK = 128

kernel_name = 'hybrid_conv_dilattn_pool_retention_step'


def rmsnorm(x, g):
    xf = x.astype(jnp.float32)
    y = xf * lax.rsqrt(jnp.mean(xf * xf, axis=-1, keepdims=True) + EPS)
    return (y * g.astype(jnp.float32)).astype(x.dtype)


def adaln(c, w, b):
    mod = (jax.nn.silu(c) @ w + b)[:, None, :]
    return jnp.split(mod, 3, axis=-1)


def split_cols(z, widths):
    idx = np.cumsum(widths)[:-1].tolist()
    return jnp.split(z, idx, axis=-1)


def alibi_slopes(n):
    return jnp.asarray(2.0 ** (-8.0 * np.arange(1, n + 1) / n), dtype=jnp.float32)


def retention_log_decay():
    return jnp.asarray(np.log(1.0 - 2.0 ** (-5.0 - np.arange(H_D))), dtype=jnp.float32)


def short_conv(bg, cg, xv, cw, cb, prev):
    u = cg * xv
    ext = jnp.concatenate([prev.astype(u.dtype), u], axis=1)
    L = u.shape[1]
    conv = cb + sum(ext[:, j:j + L] * cw[j] for j in range(CONV_W))
    return bg * conv, ext[:, L:]


def combine_patterns(outs, lses):
    wts = jax.nn.softmax(jnp.stack(lses), axis=0)
    return jnp.sum(wts[..., None] * jnp.stack(outs), axis=0)


def dilated_attn_prompt(q, k, v, slopes):
    Bn, S, H, Dh = q.shape
    qf = q.astype(jnp.float32) * (Dh ** -0.5)
    kf = k.astype(jnp.float32)
    vf = v.astype(jnp.float32)
    outs, lses = [], []
    for w, d in DIL_PATTERNS:
        nk = w // d
        span = nk * d
        sp = -(-S // span) * span
        nb = sp // span
        pad = ((0, 0), (0, sp - S), (0, 0), (0, 0))
        qs, ks, vs = (jnp.pad(a, pad).reshape(Bn, nb, nk, d, H, Dh) for a in (qf, kf, vf))

        def with_prev(a):
            prev = jnp.pad(a, ((0, 0), (1, 0), (0, 0), (0, 0), (0, 0), (0, 0)))[:, :nb]
            return jnp.concatenate([prev, a], axis=2)

        kk, vv = with_prev(ks), with_prev(vs)
        s = jnp.einsum('bnirhd,bnjrhd->bnrhij', qs, kk)
        qi = jnp.arange(nk)[:, None]
        kj = jnp.arange(2 * nk)[None, :]
        dist = nk + qi - kj
        blk = jnp.arange(nb)[:, None, None]
        valid = (dist >= 0) & (dist <= nk) & (blk * nk + kj - nk >= 0)
        bias = -slopes[:, None, None] * (dist * d).astype(jnp.float32)
        s = jnp.where(valid[None, :, None, None], s + bias, -jnp.inf)
        m = jnp.max(s, axis=-1, keepdims=True)
        p = jnp.exp(s - m)
        l = jnp.sum(p, axis=-1)
        o = jnp.einsum('bnrhij,bnjrhd->bnirhd', p, vv) / jnp.transpose(l, (0, 1, 4, 2, 3))[..., None]
        lse = jnp.transpose(m[..., 0] + jnp.log(l), (0, 1, 4, 2, 3))
        outs.append(o.reshape(Bn, sp, H, Dh)[:, :S])
        lses.append(lse.reshape(Bn, sp, H)[:, :S])
    return combine_patterns(outs, lses)


def dilated_attn_decode(q, k, v, buf_k, buf_v, slopes):
    Bn, L, H, Dh = q.shape
    wb = buf_k.shape[1]
    qf = q.astype(jnp.float32) * (Dh ** -0.5)
    allk = jnp.concatenate([buf_k.astype(jnp.float32), k.astype(jnp.float32)], axis=1)
    allv = jnp.concatenate([buf_v.astype(jnp.float32), v.astype(jnp.float32)], axis=1)
    outs, lses = [], []
    for w, d in DIL_PATTERNS:
        nk = w // d
        steps = jnp.arange(nk + 1)
        idx = wb + jnp.arange(L)[:, None] - steps[None, :] * d
        valid = idx >= 0
        idx = jnp.maximum(idx, 0)
        kg, vg = allk[:, idx], allv[:, idx]
        s = jnp.einsum('blhd,blkhd->blhk', qf, kg) - slopes[:, None] * (steps * d).astype(jnp.float32)
        s = jnp.where(valid[None, :, None, :], s, -jnp.inf)
        m = jnp.max(s, axis=-1, keepdims=True)
        p = jnp.exp(s - m)
        l = jnp.sum(p, axis=-1)
        outs.append(jnp.einsum('blhk,blkhd->blhd', p, vg) / l[..., None])
        lses.append(m[..., 0] + jnp.log(l))
    return combine_patterns(outs, lses)


def pool_mix(u, prev, pos0, pw, ps):
    Bn, L, _ = u.shape
    P = POOL_MAX - 1
    ext = jnp.concatenate([prev.astype(u.dtype), u], axis=1)
    ef = ext.astype(jnp.float32)
    cs = jnp.concatenate([jnp.zeros((Bn, 1, W_C), jnp.float32), jnp.cumsum(ef, axis=1)], axis=1)
    pos = (pos0 + jnp.arange(L)).astype(jnp.float32)[None, :, None]
    hi = cs[:, P + 1:P + 1 + L]
    groups = []
    for gi, w in enumerate(POOL_SIZES):
        sl = slice(gi * G_C, (gi + 1) * G_C)
        lo = cs[:, P + 1 - w:P + 1 - w + L, sl]
        cnt = jnp.minimum(float(w), pos + 1.0)
        groups.append((hi[..., sl] - lo) / cnt - ef[:, P:, sl])
    pooled = jnp.stack(groups, axis=2)
    mixed = jnp.einsum('blgc,gce->blge', pooled, pw.astype(jnp.float32)).reshape(Bn, L, W_C)
    return (mixed * ps.astype(jnp.float32)).astype(u.dtype), ext[:, L:]


def retention_chunk(state, q, k, v, log_g):
    L = q.shape[1]
    t = jnp.arange(L, dtype=jnp.float32)
    diff = t[:, None] - t[None, :]
    decay = jnp.where(diff >= 0, jnp.exp(jnp.maximum(diff, 0.0)[None] * log_g[:, None, None]), 0.0)
    scores = jnp.einsum('bihk,bjhk->bhij', q, k) * decay
    inner = jnp.einsum('bhij,bjhv->bihv', scores, v)
    cross = jnp.einsum('bihk,bhkv->bihv', q, state) * jnp.exp((t + 1.0)[:, None] * log_g[None, :])[None, :, :, None]
    kd = k * jnp.exp((L - 1.0 - t)[:, None] * log_g[None, :])[None, :, :, None]
    new_state = jnp.exp(L * log_g)[None, :, None, None] * state + jnp.einsum('bjhk,bjhv->bhkv', kd, v)
    return new_state, inner + cross


def retention_prompt(q, k, v, log_g):
    Bn, S, H, Dk = q.shape
    nc = S // RET_CHUNK

    def chunks(a):
        return a.reshape(Bn, nc, RET_CHUNK, H, a.shape[-1]).transpose(1, 0, 2, 3, 4)

    s0 = jnp.zeros((Bn, H, Dk, v.shape[-1]), jnp.float32)
    s_fin, o = lax.scan(lambda st, xs: retention_chunk(st, xs[0], xs[1], xs[2], log_g), s0,
                        (chunks(q), chunks(k), chunks(v)))
    return s_fin, o.transpose(1, 0, 2, 3, 4).reshape(Bn, S, H, v.shape[-1])


def even_layer(x, c, g, aw, ab, w_in, cw, cb, w_out, conv_prev, buf_k, buf_v):
    Bn, L, _ = x.shape
    shift, scale, gate = adaln(c, aw, ab)
    h = rmsnorm(x, g) * (1 + scale) + shift
    z = h @ w_in
    bg, cg, xv, ga, q, k, v, gb = split_cols(z, [W_A, W_A, W_A, W_A, W_B, W_B, W_B, W_B])
    if conv_prev is None:
        conv_prev = jnp.zeros((Bn, CONV_W - 1, W_A), x.dtype)
    y_a, conv_new = short_conv(bg, cg, xv, cw, cb, conv_prev)
    y_a = y_a * jax.nn.silu(ga)
    q, k, v = (a.reshape(Bn, L, H_B, HD_B) for a in (q, k, v))
    slopes = alibi_slopes(H_B)
    if buf_k is None:
        o = dilated_attn_prompt(q, k, v, slopes)
        keep = min(MAX_WINDOW, L)
        k_new, v_new = k[:, L - keep:], v[:, L - keep:]
    else:
        o = dilated_attn_decode(q, k, v, buf_k, buf_v, slopes)
        k_new, v_new = k, v
    y_b = o.reshape(Bn, L, W_B).astype(x.dtype) * jax.nn.silu(gb)
    out = jnp.concatenate([y_a, y_b], axis=-1) @ w_out
    return x + gate * out, conv_new, k_new, v_new


def odd_layer(x, c, g, aw, ab, w_in, pw, ps, w_out, pool_prev, ret_prev, pos0):
    Bn, L, _ = x.shape
    shift, scale, gate = adaln(c, aw, ab)
    h = rmsnorm(x, g) * (1 + scale) + shift
    z = h @ w_in
    u, gc, q, k, v, gd = split_cols(z, [W_C, W_C, H_D * DK_D, H_D * DK_D, W_D, W_D])
    if pool_prev is None:
        pool_prev = jnp.zeros((Bn, POOL_MAX - 1, W_C), x.dtype)
    y_c, pool_new = pool_mix(u, pool_prev, pos0, pw, ps)
    y_c = y_c * jax.nn.silu(gc)
    qf = q.reshape(Bn, L, H_D, DK_D).astype(jnp.float32)
    kf = k.reshape(Bn, L, H_D, DK_D).astype(jnp.float32) * (DK_D ** -0.5)
    vf = v.reshape(Bn, L, H_D, DV_D).astype(jnp.float32)
    log_g = retention_log_decay()
    if ret_prev is None:
        ret_new, o = retention_prompt(qf, kf, vf, log_g)
    else:
        ret_new, o = retention_chunk(ret_prev.astype(jnp.float32), qf, kf, vf, log_g)
    o = o * lax.rsqrt(jnp.mean(o * o, axis=-1, keepdims=True) + EPS)
    y_d = o.reshape(Bn, L, W_D).astype(x.dtype) * jax.nn.silu(gd)
    out = jnp.concatenate([y_c, y_d], axis=-1) @ w_out
    return x + gate * out, pool_new, ret_new.astype(x.dtype)


def setup_inputs(seed: int = 0) -> dict:
    key = jax.random.key(seed)
    keys = jax.random.split(key, 32)
    cnt = [0]

    def nrm(shape, s):
        kk = keys[cnt[0]]
        cnt[0] += 1
        return jax.random.normal(kk, shape, jnp.float32) * s

    d = D_MODEL
    wb = min(MAX_WINDOW, PAST_LEN)
    in_e = 4 * W_A + 4 * W_B
    in_o = 2 * W_C + 2 * H_D * DK_D + 2 * W_D
    return {
        'x_prompt': nrm((BATCH, SEQ, d), 1.0),
        'x_sample': nrm((DEC_BATCH, DEC_SEQ, d), 1.0),
        'c_prompt': nrm((BATCH, d), 1.0),
        'c_sample': nrm((DEC_BATCH, d), 1.0),
        'state_conv': nrm((N_EVEN, DEC_BATCH, CONV_W - 1, W_A), 1.0),
        'cache_win_k': nrm((N_EVEN, DEC_BATCH, wb, H_B, HD_B), 1.0),
        'cache_win_v': nrm((N_EVEN, DEC_BATCH, wb, H_B, HD_B), 1.0),
        'state_pool': nrm((N_ODD, DEC_BATCH, POOL_MAX - 1, W_C), 1.0),
        'state_ret': nrm((N_ODD, DEC_BATCH, H_D, DK_D, DV_D), 0.1),
        'norm_e': 1.0 + nrm((N_EVEN, d), 0.02),
        'ada_w_e': nrm((N_EVEN, d, 3 * d), 0.3 * d ** -0.5),
        'ada_b_e': nrm((N_EVEN, 3 * d), 0.02),
        'w_in_e': nrm((N_EVEN, d, in_e), d ** -0.5),
        'conv_w': nrm((N_EVEN, CONV_W, W_A), CONV_W ** -0.5),
        'conv_b': nrm((N_EVEN, W_A), 0.02),
        'w_out_e': nrm((N_EVEN, W_A + W_B, d), (W_A + W_B) ** -0.5),
        'norm_o': 1.0 + nrm((N_ODD, d), 0.02),
        'ada_w_o': nrm((N_ODD, d, 3 * d), 0.3 * d ** -0.5),
        'ada_b_o': nrm((N_ODD, 3 * d), 0.02),
        'w_in_o': nrm((N_ODD, d, in_o), d ** -0.5),
        'pool_w': nrm((N_ODD, N_POOL, G_C, G_C), G_C ** -0.5),
        'pool_scale': 1.0 + nrm((N_ODD, W_C), 0.1),
        'w_out_o': nrm((N_ODD, W_C + W_D, d), (W_C + W_D) ** -0.5),
        'norm_f': 1.0 + nrm((d,), 0.02),
    }


def reference(x_prompt, x_sample, c_prompt, c_sample, state_conv, cache_win_k, cache_win_v,
              state_pool, state_ret, norm_e, ada_w_e, ada_b_e, w_in_e, conv_w, conv_b, w_out_e,
              norm_o, ada_w_o, ada_b_o, w_in_o, pool_w, pool_scale, w_out_o, norm_f):
    xp, xs = x_prompt, x_sample
    conv_p, conv_s, kp_l, ks_l, vp_l, vs_l = [], [], [], [], [], []
    pool_p, pool_s, ret_p, ret_s = [], [], [], []
    for layer in range(DEPTH):
        i = layer // 2
        if layer % 2 == 0:
            pe = (norm_e[i], ada_w_e[i], ada_b_e[i], w_in_e[i], conv_w[i], conv_b[i], w_out_e[i])
            xp, cst, kn, vn = even_layer(xp, c_prompt, *pe, None, None, None)
            conv_p.append(cst); kp_l.append(kn); vp_l.append(vn)
            xs, cst, kn, vn = even_layer(xs, c_sample, *pe, state_conv[i], cache_win_k[i], cache_win_v[i])
            conv_s.append(cst); ks_l.append(kn); vs_l.append(vn)
        else:
            po = (norm_o[i], ada_w_o[i], ada_b_o[i], w_in_o[i], pool_w[i], pool_scale[i], w_out_o[i])
            xp, pst, rst = odd_layer(xp, c_prompt, *po, None, None, 0)
            pool_p.append(pst); ret_p.append(rst)
            xs, pst, rst = odd_layer(xs, c_sample, *po, state_pool[i], state_ret[i], PAST_LEN)
            pool_s.append(pst); ret_s.append(rst)
    y_prompt = rmsnorm(xp, norm_f)
    y_sample = rmsnorm(xs, norm_f)
    return (y_prompt, y_sample, jnp.stack(conv_p), jnp.stack(conv_s), jnp.stack(kp_l), jnp.stack(ks_l),
            jnp.stack(vp_l), jnp.stack(vs_l), jnp.stack(pool_p), jnp.stack(pool_s), jnp.stack(ret_p), jnp.stack(ret_s))
```

```cpp
#include <hip/hip_runtime.h>
#include <hip/hip_cooperative_groups.h>
#include <cstdio>
#include <cstdint>
namespace cg = cooperative_groups;
#ifndef SUBP
#define SUBP -1
#endif
#define SUB(id, ...) do { __VA_ARGS__; if (SUBP == (id)) { __syncthreads(); __VA_ARGS__; } } while (0)

#define LAS __attribute__((address_space(3)))
#define DI __device__ __forceinline__
typedef unsigned short bf16_t;
typedef short bf16x8 __attribute__((ext_vector_type(8)));
typedef short s16x4 __attribute__((ext_vector_type(4)));
typedef float f32x4 __attribute__((ext_vector_type(4)));
typedef float f32x16 __attribute__((ext_vector_type(16)));
typedef unsigned u32x4 __attribute__((ext_vector_type(4)));
typedef unsigned u32x2 __attribute__((ext_vector_type(2)));

constexpr int DM = 1024, SEQ = 4096, NB = 4, MP = NB * SEQ  , NS = 32  , MT = MP + NS;
constexpr int NIN_E = 8192, NIN_O = 6144;
constexpr int ZLD = NIN_E + 128;
constexpr float EPS = 1e-6f, LOG2E = 1.4426950408889634f;
constexpr size_t O_YP = 0, O_YS = 16777216, O_CONVP = 16809984, O_CONVS = 16818176, O_KP = 16883712, O_KS = 25272320, O_VP = 25305088,
                 O_VS = 33693696, O_POOLP = 33726464, O_POOLS = 33787904, O_RETP = 34279424, O_RETS = 35328000, O_END = 43716608;
constexpr size_t MiB = 1u << 20;
constexpr size_t WS_XSLOT = 1 * MiB + 65536  ;
constexpr int XCNT_WORD = 3600  ;
constexpr size_t WS_BAR = 1 * MiB  ;
constexpr size_t WS_MOD = 0, WS_WINE = 2 * MiB, WS_WOUTE = 18 * MiB, WS_WINO = 22 * MiB, WS_WOUTO = 34 * MiB, WS_PWT = 38 * MiB,
                 WS_H = 40 * MiB, WS_Y = 74 * MiB, WS_X1 = 140 * MiB, WS_POOLED = 206 * MiB, WS_Z = 240 * MiB, WS_KT = 434 * MiB, WS_VT = 466 * MiB,
                 WS_KVC = 500 * MiB, WS_AQP = 564 * MiB, WS_BSV = 628 * MiB, WS_END = 692 * MiB;
constexpr int LDS_BYTES = 147456;
constexpr int NWAVES = 8, NTHREADS = 512;

struct Params { const float* in[24]; float* out; unsigned char* ws; };

DI int ltid() { int t = threadIdx.x; asm volatile("" : "+v"(t)); return t; }
DI unsigned f2bf(float f) { unsigned u = __builtin_bit_cast(unsigned, f); return (u + 0x7fffu + ((u >> 16) & 1u)) >> 16; }
DI unsigned pk2(float lo, float hi) { unsigned r; asm("v_cvt_pk_bf16_f32 %0, %1, %2" : "=v"(r) : "v"(lo), "v"(hi)); return r; }
DI float bflo(unsigned w) { return __builtin_bit_cast(float, w << 16); }
DI float bfhi(unsigned w) { return __builtin_bit_cast(float, w & 0xffff0000u); }
DI float bf2f(bf16_t b) { return __builtin_bit_cast(float, (unsigned)b << 16); }
DI f32x4 ld4bf(const bf16_t* p) { const u32x2 w = *(const u32x2*)p; return (f32x4){bflo(w.x), bfhi(w.x), bflo(w.y), bfhi(w.y)}; }
DI float silu(float x) { return x / (1.0f + __expf(-x)); }
DI float wave_sum(float v) {
#pragma unroll
    for (int o = 1; o < 64; o <<= 1) v += __shfl_xor(v, o);
    return v;
}
DI float wave_max(float v) {
#pragma unroll
    for (int o = 1; o < 64; o <<= 1) v = fmaxf(v, __shfl_xor(v, o));
    return v;
}

namespace pg8 {
constexpr int BM = 256, BK = 64, HALF = 128, HTB = HALF * BK * 2, STAGE_BYTES = 8 * HTB, NXCD = 8, WGM = 8;
DI int lds_byte(int r, int c) { const int st = (r >> 4) * 2 + (c >> 5), rr = r & 15, cc = c & 31, ob = rr * 64 + cc * 2; return st * 1024 + (ob ^ (((ob >> 9) & 1) << 5)); }
DI void stage_rc(int b, int& R, int& C) { const int st = b / 1024, sb = b % 1024, swz = sb ^ (((sb >> 9) & 1) << 5); R = (st >> 1) * 16 + swz / 64; C = (st & 1) * 32 + (swz % 64) / 2; }
DI int perm32(int rho) { const int n = rho >> 4, i = rho & 15; return 8 * (i >> 2) + 4 * n + (i & 3); }
struct Unit { int pm, pn; };
struct Gemm { const bf16_t* A; const bf16_t* Bt; int lda, ldb, K; };

struct StaticOrder {
    int nM, nN, nwg, G, c; size_t tA, tB, aPn;
    DI void init(int M, int N, int G_, int c_, int lda, int ldb, size_t aPn_ = 0) { nM = M / BM; nN = N / BM; nwg = nM * nN; G = G_; c = c_; tA = (size_t)BM * lda * 2; tB = (size_t)BM * ldb * 2; aPn = aPn_; }
    DI bool next(int i, Unit& u) const {
        const long L = (long)i * G + c; if (L >= nwg) return false;
        int wgid = (int)L; { const int q = nwg / NXCD, r = nwg % NXCD, xcd = wgid % NXCD, off = wgid / NXCD; wgid = (xcd < r ? xcd * (q + 1) : r * (q + 1) + (xcd - r) * q) + off; }
        const int nig = WGM * nN, gid = wgid / nig, fm = gid * WGM, gsz = (nM - fm) < WGM ? (nM - fm) : WGM;
        u.pm = fm + ((wgid % nig) % gsz); u.pn = (wgid % nig) / gsz; return true;
    }
    DI size_t offA(const Unit& u) const { return (size_t)u.pm * tA + (size_t)u.pn * aPn; }
    DI size_t offB(const Unit& u) const { return (size_t)u.pn * tB; }
};

DI unsigned cvt_pk_bf16(float lo, float hi) { unsigned r; asm volatile("v_cvt_pk_bf16_f32 %0, %1, %2" : "=v"(r) : "v"(lo), "v"(hi)); return r; }

template <class Epi, class Sched, bool ALIGN_EPI = true, bool SP2 = true>
DI void gemm_phase(LAS unsigned char* lds, const Gemm g, const Sched& S, const Epi& E) {
    const int tid = ltid(), wid = __builtin_amdgcn_readfirstlane(tid >> 6), lane = tid & 63, wr = wid >> 2, wc = wid & 3, fr = lane & 15, fq = lane >> 4;
    const int K = g.K, nt = K / BK;
    unsigned voffA[2], voffB[2];
#pragma unroll
    for (int i = 0; i < 2; ++i) { int R, C; stage_rc(tid * 16 + i * 8192, R, C); const int Rb = Epi::PERM ? ((R & ~31) + perm32(R & 31)) : R;
        voffA[i] = (unsigned)(R * g.lda + C) * 2u; voffB[i] = (unsigned)(Rb * g.ldb + C) * 2u; }
    const size_t kstep = (size_t)(BK * 2);
    const size_t hstepA = (size_t)HALF * g.lda * 2, hstepB = (size_t)HALF * g.ldb * 2;
    const unsigned ldsw = (unsigned)wid * 1024u;
    const int aoff = lds_byte(wr * 64 + fr, fq * 8), boff = lds_byte(wc * 32 + fr, fq * 8);
#define PG8_SA(b, h) (((b) * 2 + (h)) * HTB)
#define PG8_SB(b, h) ((4 + (b) * 2 + (h)) * HTB)
#define PG8_STAGE(bufoff, gbase, voff) do { _Pragma("unroll") for (int _i = 0; _i < 2; ++_i) \
        __builtin_amdgcn_global_load_lds((const unsigned*)((const char*)(gbase) + (voff)[_i]), (LAS unsigned*)(lds + (bufoff) + ldsw + _i * 8192), 16, 0, 0); } while (0)
#define PG8_LDA(dst, b, h) do { _Pragma("unroll") for (int m = 0; m < 4; ++m) _Pragma("unroll") for (int k = 0; k < 2; ++k) dst[m][k] = *(const LAS bf16x8*)(lds + PG8_SA(b, h) + aoff + m * 2048 + k * 1024); } while (0)
#define PG8_LDB(dst, b, h) do { _Pragma("unroll") for (int n = 0; n < 2; ++n) _Pragma("unroll") for (int k = 0; k < 2; ++k) dst[n][k] = *(const LAS bf16x8*)(lds + PG8_SB(b, h) + boff + n * 2048 + k * 1024); } while (0)
#define PG8_MMA(ai, bj, At, Bt) do { __builtin_amdgcn_s_setprio(1); _Pragma("unroll") for (int m = 0; m < 4; ++m) _Pragma("unroll") for (int n = 0; n < 2; ++n) _Pragma("unroll") for (int k = 0; k < 2; ++k) \
        acc[ai][bj][m][n] = __builtin_amdgcn_mfma_f32_16x16x32_bf16(Bt[n][k], At[m][k], acc[ai][bj][m][n], 0, 0, 0); __builtin_amdgcn_s_setprio(0); } while (0)
#define PG8_WAIT_V(n) asm volatile("s_waitcnt vmcnt(" #n ")" ::: "memory")
#define PG8_WAIT_L(n) asm volatile("s_waitcnt lgkmcnt(" #n ")" ::: "memory")
#define PG8_BAR __builtin_amdgcn_s_barrier()
#define PG8_SCHED __builtin_amdgcn_sched_barrier(0)
    Unit cur, nxt; int ui = 0;
    if (!S.next(0, cur)) return;
    f32x4 acc[2][2][4][2];
#pragma unroll
    for (int a = 0; a < 2; ++a)
#pragma unroll
        for (int b = 0; b < 2; ++b)
#pragma unroll
            for (int m = 0; m < 4; ++m)
#pragma unroll
                for (int n = 0; n < 2; ++n) acc[a][b][m][n] = (f32x4){0.f, 0.f, 0.f, 0.f};
    bf16x8 At[4][2], B0[2][2], B1[2][2];
    const char* cA = (const char*)g.A + S.offA(cur); const char* cB = (const char*)g.Bt + S.offB(cur);
    if constexpr (SP2) {
        PG8_STAGE(PG8_SB(0, 0), cB, voffB); PG8_STAGE(PG8_SB(0, 1), cB + hstepB, voffB); PG8_STAGE(PG8_SA(0, 0), cA, voffA); PG8_STAGE(PG8_SA(0, 1), cA + hstepA, voffA);
        if (wr == 1) PG8_BAR;
        PG8_WAIT_V(2); PG8_BAR;
        PG8_STAGE(PG8_SB(1, 0), cB + kstep, voffB); PG8_STAGE(PG8_SA(1, 0), cA + kstep, voffA); PG8_STAGE(PG8_SB(1, 1), cB + hstepB + kstep, voffB);
        PG8_WAIT_V(6); PG8_BAR;
    }
    for (;;) {
        const bool has_next = S.next(ui + 1, nxt);
        const char* nA = has_next ? (const char*)g.A + S.offA(nxt) : cA; const char* nB = has_next ? (const char*)g.Bt + S.offB(nxt) : cB;
#pragma unroll 1
        for (int t = 0; t < nt; t += 2) {
            const bool last = (t == nt - 2);
            const char* a1 = cA + (size_t)(t + 1) * kstep;
            const char* a2 = last ? nA : cA + (size_t)(t + 2) * kstep; const char* b2 = last ? nB : cB + (size_t)(t + 2) * kstep;
            const char* a3 = a2 + kstep; const char* b3 = b2 + kstep;
            PG8_LDB(B0, 0, 0); PG8_LDB(B1, 0, 1); PG8_SCHED; PG8_LDA(At, 0, 0); PG8_STAGE(PG8_SA(1, 1), a1 + hstepA, voffA);
            PG8_WAIT_V(8); PG8_WAIT_L(0); PG8_BAR; PG8_MMA(0, 0, At, B0); PG8_MMA(0, 1, At, B1); PG8_BAR; PG8_SCHED;
            PG8_LDA(At, 0, 1); PG8_STAGE(PG8_SB(0, 0), b2, voffB); PG8_STAGE(PG8_SB(0, 1), b2 + hstepB, voffB); PG8_STAGE(PG8_SA(0, 0), a2, voffA);
            PG8_WAIT_V(8); PG8_WAIT_L(0); PG8_BAR; PG8_MMA(1, 0, At, B0); PG8_MMA(1, 1, At, B1); PG8_BAR; PG8_SCHED;
            PG8_LDB(B0, 1, 0); PG8_LDB(B1, 1, 1); PG8_SCHED; PG8_LDA(At, 1, 0); PG8_STAGE(PG8_SA(0, 1), a2 + hstepA, voffA);
            PG8_WAIT_V(8); PG8_WAIT_L(0); PG8_BAR; PG8_MMA(0, 0, At, B0); PG8_MMA(0, 1, At, B1); PG8_BAR; PG8_SCHED;
            PG8_LDA(At, 1, 1); PG8_STAGE(PG8_SB(1, 0), b3, voffB); PG8_STAGE(PG8_SB(1, 1), b3 + hstepB, voffB); PG8_STAGE(PG8_SA(1, 0), a3, voffA);
            PG8_WAIT_V(8); PG8_WAIT_L(0); PG8_BAR; PG8_MMA(1, 0, At, B0); PG8_MMA(1, 1, At, B1); PG8_BAR; PG8_SCHED;
        }
        if constexpr (ALIGN_EPI) { if (wr == 0) PG8_BAR; }
        E(acc, cur, wr, wc, fr, fq);
        if (!has_next) break;
#pragma unroll
        for (int a = 0; a < 2; ++a)
#pragma unroll
            for (int b = 0; b < 2; ++b)
#pragma unroll
                for (int m = 0; m < 4; ++m)
#pragma unroll
                    for (int n = 0; n < 2; ++n) acc[a][b][m][n] = (f32x4){0.f, 0.f, 0.f, 0.f};
        cur = nxt; cA = nA; cB = nB; ++ui;
        if constexpr (ALIGN_EPI) { if (wr == 1) PG8_BAR; }
    }
    PG8_WAIT_V(0);
    if constexpr (!ALIGN_EPI) { if (wr == 0) PG8_BAR; }
    PG8_BAR;
#undef PG8_SA
#undef PG8_SB
#undef PG8_STAGE
#undef PG8_LDA
#undef PG8_LDB
#undef PG8_MMA
#undef PG8_WAIT_V
#undef PG8_WAIT_L
#undef PG8_BAR
#undef PG8_SCHED
}
}

DI int crow32(int reg, int h) { return (reg & 3) + 8 * (reg >> 2) + 4 * h; }
template <class F>
DI void small_gemm(LAS unsigned char* lds, const bf16_t* A, int lda, const bf16_t* Wt, int ldb, int K, int N, int tile0, int tstride, F f) {
    const int tid = ltid(), wid = tid >> 6, lane = tid & 63, r = lane & 31, h = lane >> 5;
    LAS float* red = (LAS float*)lds;
    const int kw = K / 8;
    for (int tile = tile0; tile < N / 32; tile += tstride) {
        const int n0 = tile * 32;
        f32x16 acc;
#pragma unroll
        for (int i = 0; i < 16; ++i) acc[i] = 0.f;
        const bf16_t* ap = A + (size_t)r * lda + wid * kw + 8 * h;
        const bf16_t* bp = Wt + (size_t)(n0 + r) * ldb + wid * kw + 8 * h;
#pragma unroll 8
        for (int ks = 0; ks < kw; ks += 16) {
            const bf16x8 a = *(const bf16x8*)(ap + ks), b = *(const bf16x8*)(bp + ks);
            acc = __builtin_amdgcn_mfma_f32_32x32x16_bf16(a, b, acc, 0, 0, 0);
        }
#pragma unroll
        for (int i = 0; i < 16; ++i) red[wid * 1024 + i * 64 + lane] = acc[i];
        __syncthreads();
        for (int e = tid; e < 1024; e += NTHREADS) {
            float s = 0.f;
#pragma unroll
            for (int w = 0; w < 8; ++w) s += red[w * 1024 + e];
            const int i = e >> 6, ln = e & 63;
            f(crow32(i, ln >> 5), n0 + (ln & 31), s);
        }
        __syncthreads();
    }
}

DI int rowmap_e(int n) { if (n >= 4096) return n; const int which = n >> 10, tile = (n & 1023) >> 6, chl = n & 63; return tile * 256 + 128 * (which >> 1) + 32 * (chl >> 4) + 8 * ((chl >> 2) & 3) + (which & 1) * 4 + (chl & 3); }
DI int colmap_e(int r) { if (r >= 4096) return r; const int tile = r >> 8, cidx = r & 255, bj = cidx >> 7, wc = (cidx >> 5) & 3, fq = (cidx >> 3) & 3, e = cidx & 7; return (2 * bj + (e >> 2)) * 1024 + tile * 64 + 16 * wc + 4 * fq + (e & 3); }
DI void p0_transpose_item(const float* W, int K, int N, bf16_t* WT, LAS float* scr, int item, int lane, bool perm_e = false) {
    const int nblk = N / 32, kb = item / nblk, nb = item % nblk, k0 = 64 * kb, n0 = 32 * nb;
    float tv[32];
#pragma unroll
    for (int i = 0; i < 32; ++i) tv[i] = __builtin_nontemporal_load(W + (size_t)(k0 + 2 * i + (lane >> 5)) * N + n0 + (lane & 31));
#pragma unroll
    for (int i = 0; i < 32; ++i) scr[(2 * i + (lane >> 5)) * 33 + (lane & 31)] = tv[i];
    asm volatile("s_waitcnt lgkmcnt(0)" ::: "memory");
    const int c = lane & 7;
#pragma unroll
    for (int j = 0; j < 4; ++j) { const int n = (lane >> 3) + 8 * j; const LAS float* s = scr + (8 * c) * 33 + n;
        u32x4 o; o.x = pk2(s[0 * 33], s[1 * 33]); o.y = pk2(s[2 * 33], s[3 * 33]); o.z = pk2(s[4 * 33], s[5 * 33]); o.w = pk2(s[6 * 33], s[7 * 33]);
        *(u32x4*)(WT + (size_t)(perm_e ? rowmap_e(n0 + n) : (n0 + n)) * K + k0 + 8 * c) = o; }
    asm volatile("s_waitcnt lgkmcnt(0)" ::: "memory");
}

DI void p0_mod_unit(const Params& p, int u, LAS unsigned char* ldsb) {
    LAS float* lds = (LAS float*)ldsb;
    const int tid = ltid(), wid = tid >> 6, lane = tid & 63;
    const int l = u / 96, rem = u % 96, nb = rem >> 1, bh = rem & 1;
    const float* aw = l ? p.in[17] : p.in[10]; const float* ab = l ? p.in[18] : p.in[11];
    float* MOD = (float*)(p.ws + WS_MOD);
    for (int idx = tid; idx < 18 * 1024; idx += NTHREADS) { const int i = idx >> 10, k = idx & 1023, bi = bh * 18 + i;
        const float c = bi < 4 ? p.in[2][bi * 1024 + k] : p.in[3][(bi - 4) * 1024 + k]; lds[idx] = silu(c); }
    __syncthreads();
    float acc[18];
#pragma unroll
    for (int i = 0; i < 18; ++i) acc[i] = 0.f;
    const int n = nb * 64 + lane;
    const float* wp = aw + (size_t)(wid * 128) * 3072 + n;
#pragma unroll 2
    for (int k = 0; k < 128; k += 4) {
        const float w0 = wp[(size_t)(k + 0) * 3072], w1 = wp[(size_t)(k + 1) * 3072], w2 = wp[(size_t)(k + 2) * 3072], w3 = wp[(size_t)(k + 3) * 3072];
#pragma unroll
        for (int i = 0; i < 18; ++i) { const f32x4 s = *(const LAS f32x4*)(lds + i * 1024 + wid * 128 + k); acc[i] += s.x * w0 + s.y * w1 + s.z * w2 + s.w * w3; }
    }
    __syncthreads();
#pragma unroll
    for (int i = 0; i < 18; ++i) lds[(wid * 18 + i) * 64 + lane] = acc[i];
    __syncthreads();
    for (int o = tid; o < 18 * 64; o += NTHREADS) { const int i = o >> 6, ln = o & 63; float s = 0.f;
#pragma unroll
        for (int w = 0; w < 8; ++w) s += lds[(w * 18 + i) * 64 + ln];
        const int nn = nb * 64 + ln; __hip_atomic_store(MOD + (size_t)(l * 36 + bh * 18 + i) * 3072 + nn, s + ab[nn], __ATOMIC_RELAXED, __HIP_MEMORY_SCOPE_AGENT); }
    asm volatile("s_waitcnt vmcnt(0)" ::: "memory");
    __syncthreads();
    if (tid == 0) __hip_atomic_fetch_add((unsigned*)(p.ws + WS_BAR) + XCNT_WORD + 160, 1u, __ATOMIC_RELAXED, __HIP_MEMORY_SCOPE_AGENT);
}

DI void phase0(const Params& p, LAS unsigned char* lds) {
    const int tid = ltid(), wid = tid >> 6, lane = tid & 63, G = gridDim.x;
    SUB(0, for (int u = blockIdx.x; u < 192; u += G) p0_mod_unit(p, u, lds));
    LAS float* scr = (LAS float*)(lds + wid * 16384);
    const int gw = blockIdx.x * NWAVES + wid, NGW = G * NWAVES;
    constexpr int I_INE = 16 * 256, I_OUTE = 32 * 32, I_INO = 16 * 192, I_OUTO = 32 * 32, I_PW = 4 * 32;
    constexpr int NITEMS = I_INE + I_OUTE + I_INO + I_OUTO + I_PW;
    for (int it = (NGW - 1 - gw); it < NITEMS; it += NGW) {
        int r = it;
        if (r < I_INE) { p0_transpose_item(p.in[12], 1024, NIN_E, (bf16_t*)(p.ws + WS_WINE), scr, r, lane, true); continue; } r -= I_INE;
        if (r < I_OUTE) { p0_transpose_item(p.in[15], 2048, 1024, (bf16_t*)(p.ws + WS_WOUTE), scr, r, lane); continue; } r -= I_OUTE;
        if (r < I_INO) { p0_transpose_item(p.in[19], 1024, NIN_O, (bf16_t*)(p.ws + WS_WINO), scr, r, lane); continue; } r -= I_INO;
        if (r < I_OUTO) { p0_transpose_item(p.in[22], 2048, 1024, (bf16_t*)(p.ws + WS_WOUTO), scr, r, lane); continue; } r -= I_OUTO;
        { const int g = r >> 5; p0_transpose_item(p.in[20] + (size_t)g * 65536, 256, 256, (bf16_t*)(p.ws + WS_PWT) + (size_t)g * 65536, scr, r & 31, lane); }
    }
}

template <bool SRC_BF> DI void h_rows(const Params& p, int layer, const void* xpv  , const void* xsv  ) {
    const int tid = ltid(), wid = tid >> 6, lane = tid & 63, G = gridDim.x;
    const int gw = blockIdx.x * NWAVES + wid, NGW = G * NWAVES;
    const float* gn = layer ? p.in[16] : p.in[9];
    const float* MOD = (const float*)(p.ws + WS_MOD) + (size_t)layer * 36 * 3072;
    bf16_t* H = (bf16_t*)(p.ws + WS_H);
    for (int m0 = gw * 2; m0 < MT; m0 += NGW * 2) {
        f32x4 v[2][4]; float ss[2];
#pragma unroll
        for (int rr = 0; rr < 2; ++rr) { const int m = m0 + rr; ss[rr] = 0.f;
            if (SRC_BF) { const bf16_t* xrow = m < MP ? (const bf16_t*)xpv + (size_t)m * DM : (const bf16_t*)xsv + (size_t)(m - MP) * DM;
#pragma unroll
                for (int j = 0; j < 4; ++j) v[rr][j] = ld4bf(xrow + 4 * lane + 256 * j); }
            else { const float* xrow = m < MP ? (const float*)xpv + (size_t)m * DM : (const float*)xsv + (size_t)(m - MP) * DM;
#pragma unroll
                for (int j = 0; j < 4; ++j) v[rr][j] = *(const f32x4*)(xrow + 4 * lane + 256 * j); } }
#pragma unroll
        for (int rr = 0; rr < 2; ++rr) {
#pragma unroll
            for (int j = 0; j < 4; ++j) ss[rr] += (v[rr][j].x * v[rr][j].x + v[rr][j].y * v[rr][j].y) + (v[rr][j].z * v[rr][j].z + v[rr][j].w * v[rr][j].w); }
#pragma unroll
        for (int rr = 0; rr < 2; ++rr) { const int m = m0 + rr; const int bi = m < MP ? (m >> 12) : 4 + (m - MP); const float* md = MOD + (size_t)bi * 3072;
            const float rstd = rsqrtf(wave_sum(ss[rr]) * (1.f / DM) + EPS);
#pragma unroll
            for (int j = 0; j < 4; ++j) { const int col = 4 * lane + 256 * j;
                const f32x4 gv = *(const f32x4*)(gn + col), sh = *(const f32x4*)(md + col), sc = *(const f32x4*)(md + 1024 + col);
                const f32x4 y = v[rr][j] * rstd * gv * (sc + 1.0f) + sh;
                u32x2 o; o.x = pk2(y.x, y.y); o.y = pk2(y.z, y.w);
                *(u32x2*)(H + (size_t)m * DM + col) = o; } }
    }
}

struct EpiInE {
    static constexpr bool PERM = true;
    bf16_t* Z; float* kout; float* vout; float* convp;
    DI void operator()(const f32x4 (&acc)[2][2][4][2], const pg8::Unit& u, int wr, int wc, int fr, int fq) const {
        const int row0 = u.pm * 256 + wr * 64 + fr, colt = u.pn * 256 + wc * 32 + 8 * fq;
        if (u.pn < 16) {
            const int ch0 = u.pn * 64 + 16 * wc + 4 * fq;
#pragma unroll
            for (int ai = 0; ai < 2; ++ai)
#pragma unroll
                for (int m = 0; m < 4; ++m) { const int row = row0 + ai * 128 + m * 16; const int tl = row & 4095, b = row >> 12;
                    const f32x4 bg = acc[ai][0][m][0], cg = acc[ai][0][m][1], xv = acc[ai][1][m][0], ga = acc[ai][1][m][1];
                    const f32x4 uu = cg * xv; f32x4 gg;
#pragma unroll
                    for (int k = 0; k < 4; ++k) gg[k] = bg[k] * silu(ga[k]);
                    u32x2 wu, wg; wu.x = pk2(uu[0], uu[1]); wu.y = pk2(uu[2], uu[3]); wg.x = pk2(gg[0], gg[1]); wg.y = pk2(gg[2], gg[3]);
                    *(u32x2*)(Z + (size_t)row * ZLD + ch0) = wu; *(u32x2*)(Z + (size_t)row * ZLD + 1024 + ch0) = wg;
                    if (tl >= SEQ - 2) *(f32x4*)(convp + (size_t)(b * 2 + (tl - (SEQ - 2))) * 1024 + ch0) = uu;
                    asm volatile("" ::: "memory"); }
            return;
        }
        float* kv = nullptr; int kvc = 0;
        if (colt >= 5120 && colt < 6144) { kv = kout; kvc = colt - 5120; } else if (colt >= 6144 && colt < 7168) { kv = vout; kvc = colt - 6144; }
#pragma unroll
        for (int ai = 0; ai < 2; ++ai)
#pragma unroll
            for (int m = 0; m < 4; ++m) { const int row = row0 + ai * 128 + m * 16; const int tl = row & 4095, b = row >> 12;
#pragma unroll
                for (int bj = 0; bj < 2; ++bj) { const f32x4 v0 = acc[ai][bj][m][0], v1 = acc[ai][bj][m][1];
                    u32x4 w; w.x = pg8::cvt_pk_bf16(v0[0], v0[1]); w.y = pg8::cvt_pk_bf16(v0[2], v0[3]); w.z = pg8::cvt_pk_bf16(v1[0], v1[1]); w.w = pg8::cvt_pk_bf16(v1[2], v1[3]);
                    *(u32x4*)(Z + (size_t)row * ZLD + colt + bj * 128) = w;
                    if (kv && tl >= 2048) { float* o = kv + ((size_t)(b * 2048 + tl - 2048)) * 1024 + kvc + bj * 128; __builtin_nontemporal_store(v0, (f32x4*)o); __builtin_nontemporal_store(v1, (f32x4*)(o + 4)); } }
                asm volatile("" ::: "memory"); }
    }
};

DI void phase2(const Params& p, LAS unsigned char* lds) {
    bf16_t* H = (bf16_t*)(p.ws + WS_H); bf16_t* Z = (bf16_t*)(p.ws + WS_Z); const bf16_t* W = (const bf16_t*)(p.ws + WS_WINE);
    pg8::Gemm g{H, W, DM, DM, DM}; pg8::StaticOrder S; S.init(MP, NIN_E, gridDim.x, blockIdx.x, DM, DM);
    EpiInE E{Z, p.out + O_KP, p.out + O_VP, p.out + O_CONVP};
    pg8::gemm_phase<EpiInE, pg8::StaticOrder>(lds, g, S, E);
    float* ks = p.out + O_KS; float* vs = p.out + O_VS;
    small_gemm(lds, H + (size_t)MP * DM, DM, W, DM, DM, NIN_E, blockIdx.x, gridDim.x, [=](int row, int wrow, float v) {
        const int col = colmap_e(wrow);
        Z[(size_t)(MP + row) * ZLD + col] = (bf16_t)f2bf(v);
        if (col >= 5120 && col < 6144) ks[row * 1024 + col - 5120] = v; else if (col >= 6144 && col < 7168) vs[row * 1024 + col - 6144] = v; });
}


typedef short v4i16_t __attribute__((ext_vector_type(4)));
DI s16x4 tr_read(const LAS unsigned char* p) { return __builtin_bit_cast(s16x4, __builtin_amdgcn_ds_read_tr16_b64_v4i16((LAS v4i16_t*)p)); }
DI void unpack8(const u32x4 w, float (&f)[8]) { f[0] = bflo(w.x); f[1] = bfhi(w.x); f[2] = bflo(w.y); f[3] = bfhi(w.y); f[4] = bflo(w.z); f[5] = bfhi(w.z); f[6] = bflo(w.w); f[7] = bfhi(w.w); }
DI u32x4 pack8(const float (&f)[8]) { u32x4 w; w.x = pk2(f[0], f[1]); w.y = pk2(f[2], f[3]); w.z = pk2(f[4], f[5]); w.w = pk2(f[6], f[7]); return w; }
constexpr int VROW = 144;

DI void attn_item(const Params& p, LAS unsigned char* vb, int item, int lane) {
    const int r = item & 15, blk = (item >> 4) & 15, h = (item >> 8) & 15, b = item >> 12;
    const int c = lane & 15, quad = lane >> 4;
    const int t0 = blk * 256 + r;
    const bf16_t* Zb = (const bf16_t*)(p.ws + WS_Z) + (size_t)b * SEQ * ZLD;
    const bf16_t* qp = Zb + (size_t)(t0 + 16 * c) * ZLD + 4096 + h * 64 + quad * 8;
    const bf16x8 q0 = *(const bf16x8*)qp, q1 = *(const bf16x8*)(qp + 32);
    const float slope2 = exp2f(-0.5f * (float)(h + 1)) * LOG2E, sc2 = 0.125f * LOG2E;
    float m = -1e30f, l = 0.f;
    f32x4 o[4];
#pragma unroll
    for (int i = 0; i < 4; ++i) o[i] = (f32x4){0.f, 0.f, 0.f, 0.f};
    const int lrow = lane >> 3, lch = (lane & 7) * 8;
    const bf16_t* kbase = Zb + 5120 + h * 64 + lch;
    const bf16_t* vbase = Zb + 6144 + h * 64 + lch;
    LAS unsigned char* kb = vb + 32 * VROW;
    LAS unsigned char* kw = kb + lrow * VROW + lch * 2;
    LAS unsigned char* vw = vb + lrow * VROW + lch * 2;
    const LAS unsigned char* kr = kb + c * VROW + quad * 16;
    const LAS unsigned char* vr = vb + (4 * quad + (c >> 2)) * VROW + (c & 3) * 8;
    u32x4 kfA[4], kfB[4], kfC[4]; u32x4 vfA[4], vfB[4], vfC[4];
#define ATT_TILE(T, ld, ub) do { if ((T) < 12) { ld = 0; ub = -128 + 32 * (T); } else if ((T) < 18) { ld = 2; ub = -128 + 32 * ((T) - 12); } else { ld = 4; ub = -128 + 32 * ((T) - 18); } } while (0)
#define ATT_ISSUE(T, kf, vf) do { { int ld_, ub_; ATT_TILE(T, ld_, ub_); \
        _Pragma("unroll") for (int i_ = 0; i_ < 4; ++i_) { int r_ = t0 + ((ub_ + lrow + 8 * i_) << ld_); r_ = min(max(r_, 0), SEQ - 1); \
            kf[i_] = *(const u32x4*)(kbase + (size_t)r_ * ZLD); vf[i_] = *(const u32x4*)(vbase + (size_t)r_ * ZLD); } } } while (0)
#define ATT_BODY(T, kf, vf) do { { \
        int ld, ub; ATT_TILE(T, ld, ub); \
        asm volatile("" ::: "memory"); \
        _Pragma("unroll") for (int i_ = 0; i_ < 4; ++i_) { *(LAS u32x4*)(kw + i_ * 8 * VROW) = kf[i_]; *(LAS u32x4*)(vw + i_ * 8 * VROW) = vf[i_]; } \
        asm volatile("" ::: "memory"); \
        const bf16x8 k00 = *(const LAS bf16x8*)(kr), k01 = *(const LAS bf16x8*)(kr + 64), k10 = *(const LAS bf16x8*)(kr + 16 * VROW), k11 = *(const LAS bf16x8*)(kr + 16 * VROW + 64); \
        f32x4 s0 = (f32x4){0.f, 0.f, 0.f, 0.f}, s1 = s0; \
        s0 = __builtin_amdgcn_mfma_f32_16x16x32_bf16(k00, q0, s0, 0, 0, 0); s0 = __builtin_amdgcn_mfma_f32_16x16x32_bf16(k01, q1, s0, 0, 0, 0); \
        s1 = __builtin_amdgcn_mfma_f32_16x16x32_bf16(k10, q0, s1, 0, 0, 0); s1 = __builtin_amdgcn_mfma_f32_16x16x32_bf16(k11, q1, s1, 0, 0, 0); \
        float sv[8]; float mx = -INFINITY; \
        const int dmax = min(128 << ld, t0 + 16 * c), dbase = 16 * c - ((ub + 4 * quad) << ld); \
        _Pragma("unroll") for (int j = 0; j < 8; ++j) { \
            const int delta = dbase - ((((j >> 2) << 4) + (j & 3)) << ld); \
            const bool valid = (unsigned)delta <= (unsigned)dmax; \
            const float raw = (j < 4) ? s0[j & 3] : s1[j & 3]; \
            sv[j] = valid ? raw * sc2 - slope2 * (float)delta : -INFINITY; \
            mx = fmaxf(mx, sv[j]); } \
        mx = fmaxf(mx, __shfl_xor(mx, 16)); mx = fmaxf(mx, __shfl_xor(mx, 32)); \
        const float mn = fmaxf(m, mx), alpha = __builtin_amdgcn_exp2f(m - mn); m = mn; \
        float ps = 0.f; \
        _Pragma("unroll") for (int j = 0; j < 8; ++j) { sv[j] = __builtin_amdgcn_exp2f(sv[j] - mn); ps += sv[j]; } \
        l = l * alpha + ps; \
        _Pragma("unroll") for (int i = 0; i < 4; ++i) o[i] = o[i] * alpha; \
        u32x4 pw; pw.x = pk2(sv[0], sv[1]); pw.y = pk2(sv[2], sv[3]); pw.z = pk2(sv[4], sv[5]); pw.w = pk2(sv[6], sv[7]); \
        const bf16x8 pf = __builtin_bit_cast(bf16x8, pw); \
        _Pragma("unroll") for (int dt = 0; dt < 4; ++dt) { \
            const s16x4 lo = tr_read(vr + dt * 32), hi = tr_read(vr + 16 * VROW + dt * 32); \
            const bf16x8 vfr = __builtin_shufflevector(lo, hi, 0, 1, 2, 3, 4, 5, 6, 7); \
            o[dt] = __builtin_amdgcn_mfma_f32_16x16x32_bf16(vfr, pf, o[dt], 0, 0, 0); } \
        asm volatile("s_waitcnt lgkmcnt(0)" ::: "memory"); } } while (0)
    ATT_ISSUE(0, kfA, vfA); ATT_ISSUE(1, kfB, vfB); ATT_ISSUE(2, kfC, vfC);
#pragma unroll 1
    for (int T = 0; T < 24; T += 3) {
        ATT_BODY(T, kfA, vfA); ATT_ISSUE(T + 3, kfA, vfA);
        ATT_BODY(T + 1, kfB, vfB); ATT_ISSUE(T + 4, kfB, vfB);
        ATT_BODY(T + 2, kfC, vfC); ATT_ISSUE(T + 5, kfC, vfC);
    }
#undef ATT_BODY
#undef ATT_ISSUE
#undef ATT_TILE
    l += __shfl_xor(l, 16); l += __shfl_xor(l, 32);
    const float inv = 1.0f / l;
    const size_t row = (size_t)b * SEQ + t0 + 16 * c;
    const bf16_t* gbp = Zb + (size_t)(t0 + 16 * c) * ZLD + 7168 + h * 64 + 4 * quad;
    bf16_t* yp = (bf16_t*)(p.ws + WS_Y) + row * 2048 + 1024 + h * 64 + 4 * quad;
#pragma unroll
    for (int dt = 0; dt < 4; ++dt) {
        const u32x2 g = *(const u32x2*)(gbp + 16 * dt);
        u32x2 w; w.x = pk2(o[dt][0] * inv * silu(bflo(g.x)), o[dt][1] * inv * silu(bfhi(g.x))); w.y = pk2(o[dt][2] * inv * silu(bflo(g.y)), o[dt][3] * inv * silu(bfhi(g.y)));
        *(u32x2*)(yp + 16 * dt) = w;
    }
}

constexpr int AST_BYTES = 70656;
DI int ast_addr(int tl) { return tl * 68 + (tl >> 4) * 4; }
DI void attn_block(const Params& p, LAS unsigned char* lds, int bh, int blk, int wid, int lane) {
    const int b = bh >> 4, h = bh & 15, T0 = blk * 256;
    const int c = lane & 15, quad = lane >> 4;
    LAS float* st = (LAS float*)lds;
    LAS unsigned char* vb = lds + AST_BYTES + wid * 9216;
    const bf16_t* Zb = (const bf16_t*)(p.ws + WS_Z) + (size_t)b * SEQ * ZLD;
    const float slope2 = exp2f(-0.5f * (float)(h + 1)) * LOG2E, sc2 = 0.125f * LOG2E;
    const int lrow = lane >> 3, lch = (lane & 7) * 8;
    const bf16_t* kbase = Zb + 5120 + h * 64 + lch;
    const bf16_t* vbase = Zb + 6144 + h * 64 + lch;
    LAS unsigned char* kb = vb + 32 * VROW;
    LAS unsigned char* kw = kb + lrow * VROW + lch * 2;
    LAS unsigned char* vw = vb + lrow * VROW + lch * 2;
    const LAS unsigned char* kr = kb + c * VROW + quad * 16;
    const LAS unsigned char* vr = vb + (4 * quad + (c >> 2)) * VROW + (c & 3) * 8;
    u32x4 kfA[4], kfB[4], kfC[4], vfA[4], vfB[4], vfC[4];
    bf16x8 qa0, qa1, qb0, qb1, qna0, qna1, qnb0, qnb1; u32x2 gate[4];
    float mA = -1e30f, lA = 0.f, mB = -1e30f, lB = 0.f; f32x4 oA[4], oB[4];
#pragma unroll
    for (int i = 0; i < 4; ++i) { oA[i] = (f32x4){0.f, 0.f, 0.f, 0.f}; oB[i] = oA[i]; gate[i] = (u32x2){0u, 0u}; }
    qb0 = (bf16x8){0, 0, 0, 0, 0, 0, 0, 0}; qb1 = qb0; qnb0 = qb0; qnb1 = qb0;
#define AB_GEOM(T) const int T_ = min((int)(T), 19); const int pass = T_ < 5 ? 0 : (T_ < 10 ? 1 : 2), ti = T_ % 5, ld = 2 * pass; \
        const int qoff = pass == 0 ? 32 * wid : (pass == 1 ? (wid & 3) + 128 * (wid >> 2) : 2 * wid + (T_ >= 15 ? 1 : 0)), tp = 4 - ti, ub = -128 + 32 * tp
#define AB_QLOAD(T) do { AB_GEOM(T); (void)ub; (void)ti; (void)tp; const bf16_t* qp_ = Zb + (size_t)(T0 + qoff + (c << ld)) * ZLD + 4096 + h * 64 + quad * 8; qna0 = *(const bf16x8*)qp_; qna1 = *(const bf16x8*)(qp_ + 32); \
        if (pass < 2) { const bf16_t* qq_ = qp_ + (size_t)(16 << ld) * ZLD; qnb0 = *(const bf16x8*)qq_; qnb1 = *(const bf16x8*)(qq_ + 32); } } while (0)
#define AB_ISSUE(T, kf, vf) do { AB_GEOM(T); (void)tp; \
        _Pragma("unroll") for (int i_ = 0; i_ < 4; ++i_) { int r_ = T0 + qoff + ((ub + lrow + 8 * i_) << ld); r_ = min(max(r_, 0), SEQ - 1); \
            kf[i_] = *(const u32x4*)(kbase + (size_t)r_ * ZLD); vf[i_] = *(const u32x4*)(vbase + (size_t)r_ * ZLD); } } while (0)
#define AB_STLOAD(o, m, l, tlx) do { const LAS float* sp_ = st + ast_addr(tlx); _Pragma("unroll") for (int i_ = 0; i_ < 4; ++i_) o[i_] = *(const LAS f32x4*)(sp_ + 16 * i_ + 4 * quad); \
        m = sp_[64]; const float lt_ = sp_[65]; l = quad == 0 ? lt_ : 0.f; } while (0)
#define AB_STSTORE(o, m, l, tlx) do { float lt_ = l; lt_ += __shfl_xor(lt_, 16); lt_ += __shfl_xor(lt_, 32); LAS float* sp_ = st + ast_addr(tlx); \
        _Pragma("unroll") for (int i_ = 0; i_ < 4; ++i_) *(LAS f32x4*)(sp_ + 16 * i_ + 4 * quad) = o[i_]; if (quad == 0) { sp_[64] = m; sp_[65] = lt_; } } while (0)
#define AB_GROUP(q0, q1, o, m, l, dbase_, tlx) do { \
        f32x4 s0 = (f32x4){0.f, 0.f, 0.f, 0.f}, s1 = s0; \
        s0 = __builtin_amdgcn_mfma_f32_16x16x32_bf16(k00, q0, s0, 0, 0, 0); s0 = __builtin_amdgcn_mfma_f32_16x16x32_bf16(k01, q1, s0, 0, 0, 0); \
        s1 = __builtin_amdgcn_mfma_f32_16x16x32_bf16(k10, q0, s1, 0, 0, 0); s1 = __builtin_amdgcn_mfma_f32_16x16x32_bf16(k11, q1, s1, 0, 0, 0); \
        float sv[8]; float mx; const float b0 = -sl * (float)(dbase_); \
        if (need_mask) { \
            const int dmax = min(128, (T0 + (tlx)) >> ld); mx = -INFINITY; \
            _Pragma("unroll") for (int j = 0; j < 8; ++j) { const int jo = ((j >> 2) << 4) + (j & 3); \
                const bool valid = (unsigned)((dbase_) - jo) <= (unsigned)dmax; const float raw = (j < 4) ? s0[j & 3] : s1[j & 3]; \
                sv[j] = valid ? raw * sc2 + (b0 + sl * (float)jo) : -INFINITY; mx = fmaxf(mx, sv[j]); } \
        } else { \
            _Pragma("unroll") for (int j = 0; j < 8; ++j) { const int jo = ((j >> 2) << 4) + (j & 3); const float raw = (j < 4) ? s0[j & 3] : s1[j & 3]; sv[j] = raw * sc2 + (b0 + sl * (float)jo); } \
            mx = fmaxf(fmaxf(fmaxf(sv[0], sv[1]), fmaxf(sv[2], sv[3])), fmaxf(fmaxf(sv[4], sv[5]), fmaxf(sv[6], sv[7]))); \
        } \
        if (__builtin_amdgcn_ballot_w64(mx > m) != 0ull) {     \
            mx = fmaxf(mx, __shfl_xor(mx, 16)); mx = fmaxf(mx, __shfl_xor(mx, 32)); \
            const float mn = fmaxf(m, mx), alpha = __builtin_amdgcn_exp2f(m - mn); m = mn; l = l * alpha; \
            _Pragma("unroll") for (int i_ = 0; i_ < 4; ++i_) o[i_] = o[i_] * alpha; } \
        float ps = 0.f; \
        _Pragma("unroll") for (int j = 0; j < 8; ++j) { sv[j] = __builtin_amdgcn_exp2f(sv[j] - m); ps += sv[j]; } \
        l += ps; \
        u32x4 pw; pw.x = pk2(sv[0], sv[1]); pw.y = pk2(sv[2], sv[3]); pw.z = pk2(sv[4], sv[5]); pw.w = pk2(sv[6], sv[7]); \
        const bf16x8 pf = __builtin_bit_cast(bf16x8, pw); \
        _Pragma("unroll") for (int dt = 0; dt < 4; ++dt) o[dt] = __builtin_amdgcn_mfma_f32_16x16x32_bf16(vfr[dt], pf, o[dt], 0, 0, 0); } while (0)
#define AB_STEP(T, kf, vf) do { if ((T) < 20) { AB_GEOM(T); const int tl = qoff + (c << ld), tlb = tl + (16 << ld); \
        if (ti == 0) {     \
            if (T_ == 0 || T_ == 5 || T_ == 10) __syncthreads(); \
            qa0 = qna0; qa1 = qna1; qb0 = qnb0; qb1 = qnb1; \
            if (pass == 0) { mA = -1e30f; lA = 0.f; mB = -1e30f; lB = 0.f; _Pragma("unroll") for (int i_ = 0; i_ < 4; ++i_) { oA[i_] = (f32x4){0.f, 0.f, 0.f, 0.f}; oB[i_] = oA[i_]; } } \
            else { AB_STLOAD(oA, mA, lA, tl); if (pass == 1) AB_STLOAD(oB, mB, lB, tlb); } \
            if (pass == 2) { const bf16_t* gp_ = Zb + (size_t)(T0 + tl) * ZLD + 7168 + h * 64 + 4 * quad; _Pragma("unroll") for (int i_ = 0; i_ < 4; ++i_) gate[i_] = *(const u32x2*)(gp_ + 16 * i_); } \
        } \
        if (ti == 2) AB_QLOAD((T) + 3);     \
        asm volatile("" ::: "memory"); \
        _Pragma("unroll") for (int i_ = 0; i_ < 4; ++i_) { *(LAS u32x4*)(kw + i_ * 8 * VROW) = kf[i_]; *(LAS u32x4*)(vw + i_ * 8 * VROW) = vf[i_]; } \
        asm volatile("" ::: "memory"); \
        const bf16x8 k00 = *(const LAS bf16x8*)(kr), k01 = *(const LAS bf16x8*)(kr + 64), k10 = *(const LAS bf16x8*)(kr + 16 * VROW), k11 = *(const LAS bf16x8*)(kr + 16 * VROW + 64); \
        bf16x8 vfr[4]; \
        _Pragma("unroll") for (int dt = 0; dt < 4; ++dt) { const s16x4 lo = tr_read(vr + dt * 32), hi = tr_read(vr + 16 * VROW + dt * 32); vfr[dt] = __builtin_shufflevector(lo, hi, 0, 1, 2, 3, 4, 5, 6, 7); } \
        const int dbase = c - ub - 4 * quad; const float sl = slope2 * (float)(1 << ld); \
        const bool need_mask = (tp == 0 || tp == 4 || (T0 + qoff + (ub << ld)) < 0); \
        AB_GROUP(qa0, qa1, oA, mA, lA, dbase, tl); \
        if (pass < 2) AB_GROUP(qb0, qb1, oB, mB, lB, dbase + 16, tlb); \
        asm volatile("s_waitcnt lgkmcnt(0)" ::: "memory"); \
        if (ti == 4) {     \
            if (pass < 2) { AB_STSTORE(oA, mA, lA, tl); AB_STSTORE(oB, mB, lB, tlb); } \
            else { float lt_ = lA; lt_ += __shfl_xor(lt_, 16); lt_ += __shfl_xor(lt_, 32); \
                const float inv_ = 1.0f / lt_; bf16_t* yp_ = (bf16_t*)(p.ws + WS_Y) + ((size_t)b * SEQ + T0 + tl) * 2048 + 1024 + h * 64 + 4 * quad; \
                _Pragma("unroll") for (int i_ = 0; i_ < 4; ++i_) { const u32x2 g = gate[i_]; u32x2 w; \
                    w.x = pk2(oA[i_][0] * inv_ * silu(bflo(g.x)), oA[i_][1] * inv_ * silu(bfhi(g.x))); w.y = pk2(oA[i_][2] * inv_ * silu(bflo(g.y)), oA[i_][3] * inv_ * silu(bfhi(g.y))); \
                    *(u32x2*)(yp_ + 16 * i_) = w; } } \
        } } } while (0)
    AB_QLOAD(0);
    AB_ISSUE(0, kfA, vfA); AB_ISSUE(1, kfB, vfB); AB_ISSUE(2, kfC, vfC);
#pragma unroll 1
    for (int T = 0; T < 21; T += 3) {
        AB_STEP(T, kfA, vfA); AB_ISSUE(T + 3, kfA, vfA);
        AB_STEP(T + 1, kfB, vfB); AB_ISSUE(T + 4, kfB, vfB);
        AB_STEP(T + 2, kfC, vfC); AB_ISSUE(T + 5, kfC, vfC);
    }
#undef AB_STEP
#undef AB_GROUP
#undef AB_STSTORE
#undef AB_STLOAD
#undef AB_ISSUE
#undef AB_QLOAD
#undef AB_GEOM
}

DI void conv_item(const Params& p, int item, int lane) {
    const int chunk = item >> 1, ch = (item & 1) * 512 + lane * 8;
    const int row0 = chunk * 8, tl0 = row0 & (SEQ - 1);
    const bf16_t* Z = (const bf16_t*)(p.ws + WS_Z); bf16_t* Y = (bf16_t*)(p.ws + WS_Y);
    float cw0[8], cw1[8], cw2[8], cb[8], up1[8], up2[8];
#pragma unroll
    for (int i = 0; i < 8; ++i) { cw0[i] = p.in[13][ch + i]; cw1[i] = p.in[13][1024 + ch + i]; cw2[i] = p.in[13][2048 + ch + i]; cb[i] = p.in[14][ch + i]; up1[i] = 0.f; up2[i] = 0.f; }
    u32x4 ur[10], gr[8];
#pragma unroll
    for (int t = 0; t < 10; ++t) { ur[t] = (u32x4){0u, 0u, 0u, 0u}; if (t >= 2 || tl0 > 0) ur[t] = __builtin_nontemporal_load((const u32x4*)(Z + (size_t)(row0 - 2 + t) * ZLD + ch)); }
#pragma unroll
    for (int t = 0; t < 8; ++t) gr[t] = __builtin_nontemporal_load((const u32x4*)(Z + (size_t)(row0 + t) * ZLD + 1024 + ch));
    unpack8(ur[0], up2); unpack8(ur[1], up1);
#pragma unroll
    for (int t = 0; t < 8; ++t) {
        float u[8], g[8], y[8]; unpack8(ur[t + 2], u); unpack8(gr[t], g);
#pragma unroll
        for (int i = 0; i < 8; ++i) { const float cv = cb[i] + cw0[i] * up2[i] + cw1[i] * up1[i] + cw2[i] * u[i]; y[i] = g[i] * cv; up2[i] = up1[i]; up1[i] = u[i]; }
        *(u32x4*)(Y + (size_t)(row0 + t) * 2048 + ch) = pack8(y);
    }
}

DI void decode_pair(const Params& p, LAS float* L  , int pairidx, int wid, int lane) {
    const int item = pairidx * 2 + (wid >> 2), kq = wid & 3;
    const int b = item >> 4, h = item & 15;
    const bf16_t* zrow = (const bf16_t*)(p.ws + WS_Z) + (size_t)(MP + b) * ZLD;
    LAS float* wl = L + wid * 272; LAS float* qs = wl; LAS float* pb = wl + 64; LAS float* ob = wl + 192;
    qs[lane] = bf2f(zrow[4096 + h * 64 + lane]) * 0.125f;
    asm volatile("s_waitcnt lgkmcnt(0)" ::: "memory");
    const float slope = exp2f(-0.5f * (float)(h + 1));
    const float* ck = p.in[5]; const float* cv = p.in[6];
    const float* knew = p.out + O_KS + b * 1024 + h * 64; const float* vnew = p.out + O_VS + b * 1024 + h * 64;
    float sc[2]; float mx = -INFINITY;
#pragma unroll
    for (int i = 0; i < 2; ++i) {
        const int e = kq + 4 * (lane + 64 * i);
        sc[i] = -INFINITY;
        if (e < 387) {
            const int pi = e / 129, j = e - pi * 129, d = 1 << (2 * pi), idx = 2048 - j * d;
            const float* kr = (idx == 2048) ? knew : ck + ((size_t)(b * 2048 + idx) * 16 + h) * 64;
            float dot = 0.f;
#pragma unroll
            for (int dd = 0; dd < 64; dd += 4) { const f32x4 kv = __builtin_nontemporal_load((const f32x4*)(kr + dd)); const f32x4 qv = *(const LAS f32x4*)(qs + dd); dot += kv.x * qv.x + kv.y * qv.y + kv.z * qv.z + kv.w * qv.w; }
            sc[i] = dot - slope * (float)(j * d);
        }
        mx = fmaxf(mx, sc[i]);
    }
    mx = wave_max(mx);
    float ls = 0.f;
#pragma unroll
    for (int i = 0; i < 2; ++i) { const float pe = __expf(sc[i] - mx); ls += pe; pb[lane + 64 * i] = pe; }
    ls = wave_sum(ls);
    asm volatile("s_waitcnt lgkmcnt(0)" ::: "memory");
    const int g = lane >> 4, dq = (lane & 15) * 4;
    f32x4 acc = (f32x4){0.f, 0.f, 0.f, 0.f};
#pragma unroll 5
    for (int n = g; n < 97; n += 4) {
        const int e = kq + 4 * n;
        if (e < 387) {
            const int pi = e / 129, j = e - pi * 129, d = 1 << (2 * pi), idx = 2048 - j * d;
            const float* vr = (idx == 2048) ? vnew : cv + ((size_t)(b * 2048 + idx) * 16 + h) * 64;
            acc += __builtin_nontemporal_load((const f32x4*)(vr + dq)) * pb[n];
        }
    }
#pragma unroll
    for (int k = 0; k < 4; ++k) { float t = acc[k]; t += __shfl_xor(t, 16); t += __shfl_xor(t, 32); acc[k] = t; }
    if (lane < 16) *(LAS f32x4*)(ob + dq) = acc;
    if (lane == 0) { wl[256] = mx; wl[257] = ls; }
    __syncthreads();
    if (kq == 0 && lane < 16) {
        const LAS float* w0 = L + wid * 272;
        float M = fmaxf(fmaxf(w0[256], w0[272 + 256]), fmaxf(w0[544 + 256], w0[816 + 256]));
        float lt = 0.f; f32x4 ot = (f32x4){0.f, 0.f, 0.f, 0.f};
#pragma unroll
        for (int q = 0; q < 4; ++q) { const float f = __expf(w0[q * 272 + 256] - M); lt += f * w0[q * 272 + 257]; ot += *(const LAS f32x4*)(w0 + q * 272 + 192 + dq) * f; }
        const float inv = 1.0f / lt;
        const u32x2 gw = *(const u32x2*)(zrow + 7168 + h * 64 + dq);
        u32x2 w; w.x = pk2(ot[0] * inv * silu(bflo(gw.x)), ot[1] * inv * silu(bfhi(gw.x))); w.y = pk2(ot[2] * inv * silu(bflo(gw.y)), ot[3] * inv * silu(bfhi(gw.y)));
        *(u32x2*)((bf16_t*)(p.ws + WS_Y) + (size_t)(MP + b) * 2048 + 1024 + h * 64 + dq) = w;
    }
    __syncthreads();
}

DI void phase3(const Params& p, LAS unsigned char* lds) {
    const int tid = ltid(), wid = tid >> 6, lane = tid & 63, G = gridDim.x;
    const int gw = blockIdx.x * NWAVES + wid, NGW = G * NWAVES;
    for (int it = blockIdx.x; it < 256; it += G) decode_pair(p, (LAS float*)lds, it, wid, lane);
    LAS unsigned char* wl = lds + wid * 10240;
    if (G == 256) {
        const int x = blockIdx.x & 7, lw = (blockIdx.x >> 3) * NWAVES + wid;
        (void)lw; const int lb = blockIdx.x >> 3;
        for (int k2 = 0; k2 < 4; ++k2) attn_block(p, lds, x * 8 + 2 * k2 + (lb >> 4), lb & 15, wid, lane);
        __syncthreads();
    } else
        for (int it = gw; it < 16384; it += NGW) attn_item(p, wl, it, lane);
    for (int it = gw; it < 4096; it += NGW) conv_item(p, it, lane);
    for (int it = blockIdx.x * NTHREADS + tid; it < NS * 128; it += G * NTHREADS) {
        const int b = it >> 7, ch = (it & 127) * 8;
        const bf16_t* zr = (const bf16_t*)(p.ws + WS_Z) + (size_t)(MP + b) * ZLD + ch;
        float bg[8], cg[8], xv[8], ga[8], y[8];
        unpack8(*(const u32x4*)zr, bg); unpack8(*(const u32x4*)(zr + 1024), cg); unpack8(*(const u32x4*)(zr + 2048), xv); unpack8(*(const u32x4*)(zr + 3072), ga);
        const float* s0 = p.in[4] + (size_t)(b * 2) * 1024 + ch; const float* s1 = s0 + 1024;
        float* o0 = p.out + O_CONVS + (size_t)(b * 2) * 1024 + ch; float* o1 = o0 + 1024;
#pragma unroll
        for (int i = 0; i < 8; ++i) { const float u = cg[i] * xv[i]; const float cv = p.in[14][ch + i] + p.in[13][ch + i] * s0[i] + p.in[13][1024 + ch + i] * s1[i] + p.in[13][2048 + ch + i] * u;
            y[i] = bg[i] * cv * silu(ga[i]); o0[i] = s1[i]; o1[i] = u; }
        *(u32x4*)((bf16_t*)(p.ws + WS_Y) + (size_t)(MP + b) * 2048 + ch) = pack8(y);
    }
}

template <bool BASE_BF> struct EpiRes {
    static constexpr bool PERM = false;
    const void* base; bf16_t* out; const float* mod;
    DI void operator()(const f32x4 (&acc)[2][2][4][2], const pg8::Unit& u, int wr, int wc, int fr, int fq) const {
        const int row0 = u.pm * 256 + wr * 64 + fr, col0 = u.pn * 256 + wc * 32 + 4 * fq;
#pragma unroll
        for (int ai = 0; ai < 2; ++ai)
#pragma unroll
            for (int m = 0; m < 4; ++m) { const int row = row0 + ai * 128 + m * 16; const float* gate = mod + (size_t)(row >> 12) * 3072 + 2048;
#pragma unroll
                for (int bj = 0; bj < 2; ++bj)
#pragma unroll
                    for (int n = 0; n < 2; ++n) { const int col = col0 + bj * 128 + n * 16; const size_t off = (size_t)row * DM + col;
                        const f32x4 x = BASE_BF ? ld4bf((const bf16_t*)base + off) : __builtin_nontemporal_load((const f32x4*)((const float*)base + off));
                        const f32x4 gt = *(const f32x4*)(gate + col), y = x + gt * acc[ai][bj][m][n];
                        u32x2 w; w.x = pk2(y.x, y.y); w.y = pk2(y.z, y.w); *(u32x2*)(out + off) = w; }
                asm volatile("" ::: "memory"); }
    }
};
DI void phase_out(const Params& p, LAS unsigned char* lds, int layer) {
    const bf16_t* Y = (const bf16_t*)(p.ws + WS_Y); const bf16_t* W = (const bf16_t*)(p.ws + (layer ? WS_WOUTO : WS_WOUTE));
    bf16_t* XB = (bf16_t*)(p.ws + WS_X1); const float* mod = (const float*)(p.ws + WS_MOD) + (size_t)layer * 36 * 3072;
    pg8::Gemm g{Y, W, 2048, 2048, 2048}; pg8::StaticOrder S; S.init(MP, DM, gridDim.x, blockIdx.x, 2048, 2048);
    if (layer) { EpiRes<true> E{XB, XB, mod}; pg8::gemm_phase<EpiRes<true>, pg8::StaticOrder>(lds, g, S, E); }
    else { EpiRes<false> E{p.in[0], XB, mod}; pg8::gemm_phase<EpiRes<false>, pg8::StaticOrder>(lds, g, S, E); }
    bf16_t* os = XB + (size_t)MP * DM; const float* xs0 = p.in[1];
    small_gemm(lds, Y + (size_t)MP * 2048, 2048, W, 2048, 2048, DM, blockIdx.x, gridDim.x, [=](int row, int col, float v) {
        const float bs = layer ? bf2f(os[row * DM + col]) : xs0[row * DM + col];
        os[row * DM + col] = (bf16_t)f2bf(bs + mod[(size_t)(4 + row) * 3072 + 2048 + col] * v); });
}


struct EpiFinal {
    static constexpr bool PERM = false;
    const bf16_t* xb; const float* mod; const float* gn; float* yout; float* slots; unsigned* cnt; LAS float* X;
    DI void operator()(f32x4 (&acc)[2][2][4][2], const pg8::Unit& u, int wr, int wc, int fr, int fq) const {
        const int tid = ltid(), wid = tid >> 6, lane = tid & 63;
        const int row0 = u.pm * 256 + wr * 64 + fr, col0 = u.pn * 256 + wc * 32 + 4 * fq;
#pragma unroll
        for (int ai = 0; ai < 2; ++ai)
#pragma unroll
            for (int m = 0; m < 4; ++m) { const int row = row0 + ai * 128 + m * 16; const float* gate = mod + (size_t)(row >> 12) * 3072 + 2048; float ss = 0.f;
#pragma unroll
                for (int bj = 0; bj < 2; ++bj)
#pragma unroll
                    for (int n = 0; n < 2; ++n) { const int col = col0 + bj * 128 + n * 16;
                        const f32x4 x = ld4bf(xb + (size_t)row * DM + col), gt = *(const f32x4*)(gate + col), y = x + gt * acc[ai][bj][m][n];
                        acc[ai][bj][m][n] = y; ss += (y.x * y.x + y.y * y.y) + (y.z * y.z + y.w * y.w); }
                ss += __shfl_xor(ss, 16); ss += __shfl_xor(ss, 32);
                if (fq == 0) X[(ai * 128 + wr * 64 + m * 16 + fr) * 4 + wc] = ss;
                asm volatile("" ::: "memory"); }
        asm volatile("s_waitcnt lgkmcnt(0)" ::: "memory"); __builtin_amdgcn_s_barrier(); asm volatile("" ::: "memory");
        if (tid < 256) { const f32x4 pp = *(const LAS f32x4*)(X + tid * 4);
            __hip_atomic_store(slots + ((size_t)u.pm * 256 + tid) * 4 + u.pn, (pp.x + pp.y) + (pp.z + pp.w), __ATOMIC_RELAXED, __HIP_MEMORY_SCOPE_AGENT); }
        asm volatile("s_waitcnt vmcnt(0)" ::: "memory");
        if (tid < 256 && lane == 0) __hip_atomic_fetch_add(cnt + u.pm, 1u, __ATOMIC_RELAXED, __HIP_MEMORY_SCOPE_AGENT);
        if (wid == 0) { unsigned spins = 0;
            while ((unsigned)__builtin_amdgcn_readfirstlane(__hip_atomic_load(cnt + u.pm, __ATOMIC_RELAXED, __HIP_MEMORY_SCOPE_AGENT)) < 16u && ++spins < (1u << 22)) __builtin_amdgcn_s_sleep(2);
            __builtin_amdgcn_fence(__ATOMIC_ACQUIRE, "agent"); }
        asm volatile("s_waitcnt vmcnt(0) lgkmcnt(0)" ::: "memory"); __builtin_amdgcn_s_barrier(); asm volatile("" ::: "memory");
        if (tid < 256) { const float* sl = slots + ((size_t)u.pm * 256 + tid) * 4; float tot = 0.f;
#pragma unroll
            for (int t = 0; t < 4; ++t) tot += __hip_atomic_load(sl + t, __ATOMIC_RELAXED, __HIP_MEMORY_SCOPE_AGENT);
            X[1024 + tid] = rsqrtf(tot * (1.0f / DM) + EPS); }
        asm volatile("s_waitcnt vmcnt(0) lgkmcnt(0)" ::: "memory"); __builtin_amdgcn_s_barrier(); asm volatile("" ::: "memory");
#pragma unroll
        for (int ai = 0; ai < 2; ++ai)
#pragma unroll
            for (int m = 0; m < 4; ++m) { const int rl = ai * 128 + wr * 64 + m * 16 + fr; const float rs = X[1024 + rl]; float* orow = yout + ((size_t)u.pm * 256 + rl) * DM;
#pragma unroll
                for (int bj = 0; bj < 2; ++bj)
#pragma unroll
                    for (int n = 0; n < 2; ++n) { const int col = col0 + bj * 128 + n * 16;
                        __builtin_nontemporal_store(acc[ai][bj][m][n] * rs * *(const f32x4*)(gn + col), (f32x4*)(orow + col)); }
                asm volatile("" ::: "memory"); }
        asm volatile("s_waitcnt lgkmcnt(0)" ::: "memory"); __builtin_amdgcn_s_barrier(); asm volatile("" ::: "memory");
    }
};
DI void phase_out_final(const Params& p, LAS unsigned char* lds) {
    const int tid = ltid(), wid = tid >> 6;
    const bf16_t* Y = (const bf16_t*)(p.ws + WS_Y); const bf16_t* W = (const bf16_t*)(p.ws + WS_WOUTO);
    const bf16_t* XB = (const bf16_t*)(p.ws + WS_X1); const float* mod = (const float*)(p.ws + WS_MOD) + (size_t)36 * 3072;
    float* slots = (float*)(p.ws + WS_XSLOT); unsigned* cnt = (unsigned*)(p.ws + WS_BAR) + XCNT_WORD;
    pg8::Gemm g{Y, W, 2048, 2048, 2048}; pg8::StaticOrder S; S.init(MP, DM, gridDim.x, blockIdx.x, 2048, 2048);
    EpiFinal E{XB, mod, p.in[23], p.out + O_YP, slots, cnt, (LAS float*)(lds + 131072 + 1024)};
    pg8::gemm_phase<EpiFinal, pg8::StaticOrder>(lds, g, S, E);
    LAS float* T = (LAS float*)(lds + 40960); LAS float* Rs = T + 32 * 33;
    const bf16_t* xs = XB + (size_t)MP * DM;
    small_gemm(lds, Y + (size_t)MP * 2048, 2048, W, 2048, 2048, DM, blockIdx.x, gridDim.x, [=](int row, int col, float v) {
        T[row * 33 + (col & 31)] = bf2f(xs[row * DM + col]) + mod[(size_t)(4 + row) * 3072 + 2048 + col] * v; });
    if (blockIdx.x < 32) {
        float* ss_slots = slots + (size_t)MP * 4; const int n0 = blockIdx.x * 32;
        if (tid < 32) { float ss = 0.f;
#pragma unroll 8
            for (int c = 0; c < 32; ++c) { const float t = T[tid * 33 + c]; ss += t * t; }
            __hip_atomic_store(ss_slots + tid * 32 + blockIdx.x, ss, __ATOMIC_RELAXED, __HIP_MEMORY_SCOPE_AGENT); }
        asm volatile("s_waitcnt vmcnt(0)" ::: "memory");
        if (tid == 0) __hip_atomic_fetch_add(cnt + 64, 1u, __ATOMIC_RELAXED, __HIP_MEMORY_SCOPE_AGENT);
        if (wid == 0) { unsigned spins = 0;
            while ((unsigned)__builtin_amdgcn_readfirstlane(__hip_atomic_load(cnt + 64, __ATOMIC_RELAXED, __HIP_MEMORY_SCOPE_AGENT)) < 32u && ++spins < (1u << 22)) __builtin_amdgcn_s_sleep(2);
            __builtin_amdgcn_fence(__ATOMIC_ACQUIRE, "agent"); }
        __syncthreads();
        if (tid < 32) { float tot = 0.f;
            for (int t = 0; t < 32; ++t) tot += __hip_atomic_load(ss_slots + tid * 32 + t, __ATOMIC_RELAXED, __HIP_MEMORY_SCOPE_AGENT);
            Rs[tid] = rsqrtf(tot * (1.0f / DM) + EPS); }
        __syncthreads();
        for (int e = tid; e < 1024; e += NTHREADS) { const int r = e >> 5, c = e & 31; p.out[O_YS + (size_t)r * DM + n0 + c] = T[r * 33 + c] * Rs[r] * p.in[23][n0 + c]; }
    }
}


struct EpiMid {
    static constexpr bool PERM = false;
    const float* xin; const float* mod0; const float* mod1; const float* gno; bf16_t* xb; bf16_t* H; float* slots; unsigned* cnt; LAS float* X;
    DI void operator()(f32x4 (&acc)[2][2][4][2], const pg8::Unit& u, int wr, int wc, int fr, int fq) const {
        const int tid = ltid(), wid = tid >> 6, lane = tid & 63;
        const int row0 = u.pm * 256 + wr * 64 + fr, col0 = u.pn * 256 + wc * 32 + 4 * fq;
#pragma unroll
        for (int ai = 0; ai < 2; ++ai)
#pragma unroll
            for (int m = 0; m < 4; ++m) { const int row = row0 + ai * 128 + m * 16; const float* gate = mod0 + (size_t)(row >> 12) * 3072 + 2048; float ss = 0.f;
#pragma unroll
                for (int bj = 0; bj < 2; ++bj)
#pragma unroll
                    for (int n = 0; n < 2; ++n) { const int col = col0 + bj * 128 + n * 16; const size_t off = (size_t)row * DM + col;
                        const f32x4 x = __builtin_nontemporal_load((const f32x4*)(xin + off)), gt = *(const f32x4*)(gate + col), y = x + gt * acc[ai][bj][m][n];
                        acc[ai][bj][m][n] = y; ss += (y.x * y.x + y.y * y.y) + (y.z * y.z + y.w * y.w);
                        u32x2 w; w.x = pk2(y.x, y.y); w.y = pk2(y.z, y.w); *(u32x2*)(xb + off) = w; }
                ss += __shfl_xor(ss, 16); ss += __shfl_xor(ss, 32);
                if (fq == 0) X[(ai * 128 + wr * 64 + m * 16 + fr) * 4 + wc] = ss;
                asm volatile("" ::: "memory"); }
        asm volatile("s_waitcnt lgkmcnt(0)" ::: "memory"); __builtin_amdgcn_s_barrier(); asm volatile("" ::: "memory");
        if (tid < 256) { const f32x4 pp = *(const LAS f32x4*)(X + tid * 4);
            __hip_atomic_store(slots + ((size_t)u.pm * 256 + tid) * 4 + u.pn, (pp.x + pp.y) + (pp.z + pp.w), __ATOMIC_RELAXED, __HIP_MEMORY_SCOPE_AGENT); }
        asm volatile("s_waitcnt vmcnt(0)" ::: "memory");
        if (tid < 256 && lane == 0) __hip_atomic_fetch_add(cnt + u.pm, 1u, __ATOMIC_RELAXED, __HIP_MEMORY_SCOPE_AGENT);
        if (wid == 0) { unsigned spins = 0;
            while ((unsigned)__builtin_amdgcn_readfirstlane(__hip_atomic_load(cnt + u.pm, __ATOMIC_RELAXED, __HIP_MEMORY_SCOPE_AGENT)) < 16u && ++spins < (1u << 22)) __builtin_amdgcn_s_sleep(2);
            __builtin_amdgcn_fence(__ATOMIC_ACQUIRE, "agent"); }
        asm volatile("s_waitcnt vmcnt(0) lgkmcnt(0)" ::: "memory"); __builtin_amdgcn_s_barrier(); asm volatile("" ::: "memory");
        if (tid < 256) { const float* sl = slots + ((size_t)u.pm * 256 + tid) * 4; float tot = 0.f;
#pragma unroll
            for (int t = 0; t < 4; ++t) tot += __hip_atomic_load(sl + t, __ATOMIC_RELAXED, __HIP_MEMORY_SCOPE_AGENT);
            X[1024 + tid] = rsqrtf(tot * (1.0f / DM) + EPS); }
        asm volatile("s_waitcnt vmcnt(0) lgkmcnt(0)" ::: "memory"); __builtin_amdgcn_s_barrier(); asm volatile("" ::: "memory");
#pragma unroll
        for (int ai = 0; ai < 2; ++ai)
#pragma unroll
            for (int m = 0; m < 4; ++m) { const int rl = ai * 128 + wr * 64 + m * 16 + fr; const float rs = X[1024 + rl]; const size_t row = (size_t)u.pm * 256 + rl;
                const float* md = mod1 + (row >> 12) * 3072;
#pragma unroll
                for (int bj = 0; bj < 2; ++bj)
#pragma unroll
                    for (int n = 0; n < 2; ++n) { const int col = col0 + bj * 128 + n * 16;
                        const f32x4 gv = *(const f32x4*)(gno + col), sh = *(const f32x4*)(md + col), sc = *(const f32x4*)(md + 1024 + col);
                        const f32x4 hv = acc[ai][bj][m][n] * rs * gv * (sc + 1.0f) + sh;
                        u32x2 w; w.x = pk2(hv.x, hv.y); w.y = pk2(hv.z, hv.w); *(u32x2*)(H + row * DM + col) = w; }
                asm volatile("" ::: "memory"); }
        asm volatile("s_waitcnt lgkmcnt(0)" ::: "memory"); __builtin_amdgcn_s_barrier(); asm volatile("" ::: "memory");
    }
};
DI void phase_out_mid(const Params& p, LAS unsigned char* lds) {
    const int tid = ltid(), wid = tid >> 6;
    const bf16_t* Y = (const bf16_t*)(p.ws + WS_Y); const bf16_t* W = (const bf16_t*)(p.ws + WS_WOUTE);
    bf16_t* XB = (bf16_t*)(p.ws + WS_X1); bf16_t* H = (bf16_t*)(p.ws + WS_H);
    const float* mod0 = (const float*)(p.ws + WS_MOD); const float* mod1 = mod0 + (size_t)36 * 3072;
    float* slots = (float*)(p.ws + WS_XSLOT + 512 * 1024); unsigned* cnt = (unsigned*)(p.ws + WS_BAR) + XCNT_WORD + 80;
    pg8::Gemm g{Y, W, 2048, 2048, 2048}; pg8::StaticOrder S; S.init(MP, DM, gridDim.x, blockIdx.x, 2048, 2048);
    EpiMid E{p.in[0], mod0, mod1, p.in[16], XB, H, slots, cnt, (LAS float*)(lds + 131072 + 1024)};
    pg8::gemm_phase<EpiMid, pg8::StaticOrder>(lds, g, S, E);
    LAS float* T = (LAS float*)(lds + 40960); LAS float* Rs = T + 32 * 33;
    const float* xs0 = p.in[1];
    small_gemm(lds, Y + (size_t)MP * 2048, 2048, W, 2048, 2048, DM, blockIdx.x, gridDim.x, [=](int row, int col, float v) {
        const float x1 = xs0[row * DM + col] + mod0[(size_t)(4 + row) * 3072 + 2048 + col] * v;
        T[row * 33 + (col & 31)] = x1; XB[(size_t)(MP + row) * DM + col] = (bf16_t)f2bf(x1); });
    if (blockIdx.x < 32) {
        float* ss_slots = slots + (size_t)MP * 4; const int n0 = blockIdx.x * 32;
        if (tid < 32) { float ss = 0.f;
#pragma unroll 8
            for (int c = 0; c < 32; ++c) { const float t = T[tid * 33 + c]; ss += t * t; }
            __hip_atomic_store(ss_slots + tid * 32 + blockIdx.x, ss, __ATOMIC_RELAXED, __HIP_MEMORY_SCOPE_AGENT); }
        asm volatile("s_waitcnt vmcnt(0)" ::: "memory");
        if (tid == 0) __hip_atomic_fetch_add(cnt + 64, 1u, __ATOMIC_RELAXED, __HIP_MEMORY_SCOPE_AGENT);
        if (wid == 0) { unsigned spins = 0;
            while ((unsigned)__builtin_amdgcn_readfirstlane(__hip_atomic_load(cnt + 64, __ATOMIC_RELAXED, __HIP_MEMORY_SCOPE_AGENT)) < 32u && ++spins < (1u << 22)) __builtin_amdgcn_s_sleep(2);
            __builtin_amdgcn_fence(__ATOMIC_ACQUIRE, "agent"); }
        __syncthreads();
        if (tid < 32) { float tot = 0.f;
            for (int t = 0; t < 32; ++t) tot += __hip_atomic_load(ss_slots + tid * 32 + t, __ATOMIC_RELAXED, __HIP_MEMORY_SCOPE_AGENT);
            Rs[tid] = rsqrtf(tot * (1.0f / DM) + EPS); }
        __syncthreads();
        for (int e = tid; e < 1024; e += NTHREADS) { const int r = e >> 5, col = n0 + (e & 31); const float* md = mod1 + (size_t)(4 + r) * 3072;
            H[(size_t)(MP + r) * DM + col] = (bf16_t)f2bf(T[r * 33 + (e & 31)] * Rs[r] * p.in[16][col] * (md[1024 + col] + 1.0f) + md[col]); }
    }
}

struct RetOrder {
    int G, c, kind;
    DI bool next(int i, pg8::Unit& u) const { const int L = i * G + c; if (L >= 256) return false; u.pm = L; u.pn = 0; return true; }
    DI size_t offA(const pg8::Unit& u) const {
        const int b = u.pm >> 6, h = (u.pm >> 4) & 3, cc = u.pm & 15;
        if (kind == 0) return ((size_t)u.pm * 256 * 512 + 256) * 2;
        return (size_t)u.pm * 256 * 512 * 2;
    }
    DI size_t offB(const pg8::Unit& u) const {
        const int b = u.pm >> 6, h = (u.pm >> 4) & 3, cc = u.pm & 15;
        if (kind == 0) return ((size_t)(h * 256) * MP + (size_t)b * SEQ + cc * 256) * 2;
        if (kind == 1) return (((size_t)b * SEQ + cc * 256) * NIN_O + 3072 + h * 256) * 2;
        return (size_t)u.pm * 256 * 512 * 2;
    }
};

DI float ret_log2g(int h) { return log2f(1.0f - exp2f(-5.0f - (float)h)); }
DI float swap_adj(float v) { return __builtin_bit_cast(float, __builtin_amdgcn_update_dpp(0, __builtin_bit_cast(int, v), 0xB1, 0xF, 0xF, true)); }
struct EpiInO {
    static constexpr bool PERM = true;
    bf16_t* Z1; bf16_t* KTD; bf16_t* AQP; bf16_t* BSV;
    DI void operator()(const f32x4 (&acc)[2][2][4][2], const pg8::Unit& u, int wr, int wc, int fr, int fq) const {
        const int row0 = u.pm * 256 + wr * 64 + fr, colt = u.pn * 256 + wc * 32 + 8 * fq;
        const int region = u.pn >> 2, h = u.pn & 3;
        const float lg = ret_log2g(h);
#pragma unroll
        for (int ai = 0; ai < 2; ++ai)
#pragma unroll
            for (int m = 0; m < 4; ++m) { const int row = row0 + ai * 128 + m * 16; const int i = row & 255;
                const size_t ru = ((size_t)(((row >> 12) * 4 + h) * 16 + ((row >> 8) & 15))) * 256;
#pragma unroll
                for (int bj = 0; bj < 2; ++bj) { f32x4 v0 = acc[ai][bj][m][0], v1 = acc[ai][bj][m][1]; const int col = colt + bj * 128;
                    if (region == 2) {
                        const float gq = exp2f((float)(i + 1) * lg);
                        u32x4 w; w.x = pg8::cvt_pk_bf16(v0[0] * gq, v0[1] * gq); w.y = pg8::cvt_pk_bf16(v0[2] * gq, v0[3] * gq); w.z = pg8::cvt_pk_bf16(v1[0] * gq, v1[1] * gq); w.w = pg8::cvt_pk_bf16(v1[2] * gq, v1[3] * gq);
                        *(u32x4*)(AQP + (ru + i) * 512 + (col & 255)) = w;
                    }
                    if (region == 3) {
                        const float dec = exp2f((float)(255 - i) * lg) * 0.0625f;
                        const float tv[8] = {v0[0] * dec, v0[1] * dec, v0[2] * dec, v0[3] * dec, v1[0] * dec, v1[1] * dec, v1[2] * dec, v1[3] * dec};
                        const bool odd = fr & 1;
                        unsigned* t = (unsigned*)(KTD + (size_t)(col - 3072 + (odd ? 1 : 0)) * MP + (row & ~1));
#pragma unroll
                        for (int k = 0; k < 4; ++k) { const float rc = swap_adj(odd ? tv[2 * k] : tv[2 * k + 1]);
                            t[(size_t)k * MP] = odd ? pk2(rc, tv[2 * k + 1]) : pk2(tv[2 * k], rc); }
                        v0 = v0 * 0.0625f; v1 = v1 * 0.0625f;
                    }
                    if (region == 2) { } else
                    if (region == 4) {
                        const float tv[8] = {v0[0], v0[1], v0[2], v0[3], v1[0], v1[1], v1[2], v1[3]};
                        const bool odd = fr & 1;
                        unsigned* t = (unsigned*)(BSV + (ru + (col & 255) + (odd ? 1 : 0)) * 512 + 256 + (i & ~1));
#pragma unroll
                        for (int k = 0; k < 4; ++k) { const float rc = swap_adj(odd ? tv[2 * k] : tv[2 * k + 1]);
                            t[k * 512] = odd ? pk2(rc, tv[2 * k + 1]) : pk2(tv[2 * k], rc); }
                    } else {
                        if (region == 1 || region == 5) {
#pragma unroll
                            for (int k = 0; k < 4; ++k) { v0[k] = silu(v0[k]); v1[k] = silu(v1[k]); } }
                        u32x4 w; w.x = pg8::cvt_pk_bf16(v0[0], v0[1]); w.y = pg8::cvt_pk_bf16(v0[2], v0[3]); w.z = pg8::cvt_pk_bf16(v1[0], v1[1]); w.w = pg8::cvt_pk_bf16(v1[2], v1[3]);
                        *(u32x4*)(Z1 + (size_t)row * NIN_O + col) = w;
                    }
                    asm volatile("" ::: "memory"); } }
    }
};
DI void phase6(const Params& p, LAS unsigned char* lds) {
    bf16_t* H = (bf16_t*)(p.ws + WS_H); bf16_t* Z1 = (bf16_t*)(p.ws + WS_Z); const bf16_t* W = (const bf16_t*)(p.ws + WS_WINO);
    pg8::Gemm g{H, W, DM, DM, DM}; pg8::StaticOrder S; S.init(MP, NIN_O, gridDim.x, blockIdx.x, DM, DM);
    EpiInO E{Z1, (bf16_t*)(p.ws + WS_KT), (bf16_t*)(p.ws + WS_AQP), (bf16_t*)(p.ws + WS_BSV)};
    pg8::gemm_phase<EpiInO, pg8::StaticOrder>(lds, g, S, E);
    small_gemm(lds, H + (size_t)MP * DM, DM, W, DM, DM, NIN_O, blockIdx.x, gridDim.x, [=](int row, int col, float v) {
        const int rg = col >> 10;
        Z1[(size_t)(MP + row) * NIN_O + col] = (bf16_t)f2bf(rg == 3 ? v * 0.0625f : (rg == 1 || rg == 5) ? silu(v) : v); });
}

struct EpiKV {
    static constexpr bool PERM = true;
    bf16_t* KVC;
    DI void operator()(const f32x4 (&acc)[2][2][4][2], const pg8::Unit& u, int wr, int wc, int fr, int fq) const {
        bf16_t* o = KVC + (size_t)u.pm * 65536 + (size_t)(wr * 64 + fr) * 256 + wc * 32 + 8 * fq;
#pragma unroll
        for (int ai = 0; ai < 2; ++ai)
#pragma unroll
            for (int m = 0; m < 4; ++m)
#pragma unroll
                for (int bj = 0; bj < 2; ++bj) { const f32x4 v0 = acc[ai][bj][m][0], v1 = acc[ai][bj][m][1];
                    u32x4 w; w.x = pk2(v0[0], v0[1]); w.y = pk2(v0[2], v0[3]); w.z = pk2(v1[0], v1[1]); w.w = pk2(v1[2], v1[3]);
                    *(u32x4*)(o + (size_t)(ai * 128 + m * 16) * 256 + bj * 128) = w; }
    }
};
struct EpiScore {
    static constexpr bool PERM = true;
    bf16_t* AQP;
    DI void operator()(const f32x4 (&acc)[2][2][4][2], const pg8::Unit& u, int wr, int wc, int fr, int fq) const {
        const float lg = ret_log2g((u.pm >> 4) & 3);
        int j0 = wc * 32 + 8 * fq; asm volatile("" : "+v"(j0));
        float gj[2][8];
#pragma unroll
        for (int bj = 0; bj < 2; ++bj)
#pragma unroll
            for (int k = 0; k < 8; ++k) gj[bj][k] = exp2f(-(float)(j0 + bj * 128 + k + 1) * lg);
#pragma unroll
        for (int ai = 0; ai < 2; ++ai)
#pragma unroll
            for (int m = 0; m < 4; ++m) { const int i = ai * 128 + wr * 64 + m * 16 + fr;
#pragma unroll
                for (int bj = 0; bj < 2; ++bj) { const int j = j0 + bj * 128; const f32x4 v0 = acc[ai][bj][m][0], v1 = acc[ai][bj][m][1];
                    float y[8];
#pragma unroll
                    for (int k = 0; k < 8; ++k) { const float a = k < 4 ? v0[k & 3] : v1[k & 3]; y[k] = (i - j - k) >= 0 ? a * gj[bj][k] : 0.f; }
                    *(u32x4*)(AQP + ((size_t)u.pm * 256 + i) * 512 + 256 + j) = pack8(y); }
                asm volatile("" ::: "memory"); }
    }
};
template <int W> DI void pooled_run(const Params& p, int run, int gi, int cl) {
    const int row0 = run * 8, tl0 = row0 & (SEQ - 1), b = row0 >> 12, ch = gi * 256 + cl * 8;
    const bf16_t* Z1 = (const bf16_t*)(p.ws + WS_Z); bf16_t* PO = (bf16_t*)(p.ws + WS_POOLED);
    u32x4 rw[W + 7];
#pragma unroll
    for (int i = 0; i < W + 7; ++i) { const int tl = tl0 - (W - 1) + i; rw[i] = (u32x4){0u, 0u, 0u, 0u};
        if (tl >= 0) rw[i] = *(const u32x4*)(Z1 + (size_t)(row0 - (W - 1) + i) * NIN_O + ch); }
    float S[8];
#pragma unroll
    for (int k = 0; k < 8; ++k) S[k] = 0.f;
#pragma unroll
    for (int i = 0; i < W - 1; ++i) { float t[8]; unpack8(rw[i], t);
#pragma unroll
        for (int k = 0; k < 8; ++k) S[k] += t[k]; }
#pragma unroll
    for (int t = 0; t < 8; ++t) {
        const int tl = tl0 + t; float uv[8], y[8], od[8]; unpack8(rw[W - 1 + t], uv); unpack8(rw[t], od);
        const float rc = 1.0f / (float)min(W, tl + 1);
#pragma unroll
        for (int k = 0; k < 8; ++k) { S[k] += uv[k]; y[k] = S[k] * rc - uv[k]; S[k] -= od[k]; }
        *(u32x4*)(PO + (size_t)(row0 + t) * DM + ch) = pack8(y);
        if (tl >= SEQ - 15) { float* o = p.out + O_POOLP + (size_t)(b * 15 + (tl - (SEQ - 15))) * 1024 + ch; *(f32x4*)o = (f32x4){uv[0], uv[1], uv[2], uv[3]}; *(f32x4*)(o + 4) = (f32x4){uv[4], uv[5], uv[6], uv[7]}; }
    }
}
DI void phase7(const Params& p, LAS unsigned char* lds) {
    const int tid = ltid(), wid = tid >> 6, lane = tid & 63, G = gridDim.x;
    const int gw = blockIdx.x * NWAVES + wid, NGW = G * NWAVES;
    {
        pg8::Gemm g{(const bf16_t*)(p.ws + WS_BSV), (const bf16_t*)(p.ws + WS_KT), 512, MP, 256}; RetOrder S{G, (int)blockIdx.x, 0};
        EpiKV E{(bf16_t*)(p.ws + WS_KVC)};
        SUB(70, pg8::gemm_phase<EpiKV, RetOrder>(lds, g, S, E));
    }
    {
        pg8::Gemm g{(const bf16_t*)(p.ws + WS_AQP), (const bf16_t*)(p.ws + WS_Z), 512, NIN_O, 256}; RetOrder S{G, (int)blockIdx.x, 1};
        EpiScore E{(bf16_t*)(p.ws + WS_AQP)};
        SUB(71, pg8::gemm_phase<EpiScore, RetOrder>(lds, g, S, E));
    }
    SUB(72, for (int it = gw; it < 4096; it += NGW) {
        const int gi = it & 3, run = (it >> 2) * 2 + (lane >> 5), cl = lane & 31;
        if (gi == 0) pooled_run<2>(p, run, 0, cl); else if (gi == 1) pooled_run<4>(p, run, 1, cl); else if (gi == 2) pooled_run<8>(p, run, 2, cl); else pooled_run<16>(p, run, 3, cl);
    });
    for (int it = blockIdx.x * NTHREADS + tid; it < NS * 256; it += G * NTHREADS) {
        const int b = it >> 8, ch = (it & 255) * 4, w = 2 << (ch >> 8);
        const u32x2 uw = *(const u32x2*)((const bf16_t*)(p.ws + WS_Z) + (size_t)(MP + b) * NIN_O + ch);
        const f32x4 u0 = (f32x4){bflo(uw.x), bfhi(uw.x), bflo(uw.y), bfhi(uw.y)};
        const float* prev = p.in[7] + (size_t)(b * 15) * 1024 + ch; float* po = p.out + O_POOLS + (size_t)(b * 15) * 1024 + ch;
        f32x4 pr[15];
#pragma unroll
        for (int j = 0; j < 15; ++j) pr[j] = *(const f32x4*)(prev + (size_t)j * 1024);
        f32x4 s = u0;
#pragma unroll
        for (int i = 1; i < 16; ++i) if (i < w) s += pr[15 - i];
        const f32x4 y = s * (1.0f / (float)w) - u0;
        u32x2 o; o.x = pk2(y.x, y.y); o.y = pk2(y.z, y.w);
        *(u32x2*)((bf16_t*)(p.ws + WS_POOLED) + (size_t)(MP + b) * DM + ch) = o;
#pragma unroll
        for (int j = 0; j < 14; ++j) *(f32x4*)(po + (size_t)j * 1024) = pr[j + 1];
        *(f32x4*)(po + (size_t)14 * 1024) = u0;
    }
}

DI void ret_sample_item(const Params& p, LAS unsigned char* ldsb, int item);
struct EpiPool {
    static constexpr bool PERM = true;
    const bf16_t* Z1; bf16_t* Y; const float* ps;
    DI void operator()(const f32x4 (&acc)[2][2][4][2], const pg8::Unit& u, int wr, int wc, int fr, int fq) const {
        const int row0 = u.pm * 256 + wr * 64 + fr, colt = u.pn * 256 + wc * 32 + 8 * fq;
#pragma unroll
        for (int ai = 0; ai < 2; ++ai)
#pragma unroll
            for (int m = 0; m < 4; ++m) { const size_t row = row0 + ai * 128 + m * 16;
#pragma unroll
                for (int bj = 0; bj < 2; ++bj) { const int col = colt + bj * 128; const f32x4 v0 = acc[ai][bj][m][0], v1 = acc[ai][bj][m][1];
                    float gc[8]; unpack8(__builtin_nontemporal_load((const u32x4*)(Z1 + row * NIN_O + 1024 + col)), gc);
                    const f32x4 s0 = *(const f32x4*)(ps + col), s1 = *(const f32x4*)(ps + col + 4);
                    float y[8];
#pragma unroll
                    for (int k = 0; k < 4; ++k) { y[k] = v0[k] * s0[k] * gc[k]; y[4 + k] = v1[k] * s1[k] * gc[4 + k]; }
                    *(u32x4*)(Y + row * 2048 + col) = pack8(y); }
                asm volatile("" ::: "memory"); }
    }
};
DI void phase8(const Params& p, LAS unsigned char* lds) {
    const int tid = ltid(), G = gridDim.x;
    const bf16_t* Z1 = (const bf16_t*)(p.ws + WS_Z); bf16_t* Y = (bf16_t*)(p.ws + WS_Y); const bf16_t* PO = (const bf16_t*)(p.ws + WS_POOLED); const bf16_t* PW = (const bf16_t*)(p.ws + WS_PWT);
    {
        pg8::Gemm g{PO, PW, DM, 256, 256}; pg8::StaticOrder S; S.init(MP, DM, G, blockIdx.x, DM, 256, 512);
        EpiPool E{Z1, Y, p.in[21]};
        pg8::gemm_phase<EpiPool, pg8::StaticOrder>(lds, g, S, E);
    }
    const float* ps = p.in[21];
    for (int gi = 0; gi < 4; ++gi)
        small_gemm(lds, PO + (size_t)MP * DM + gi * 256, DM, PW + (size_t)gi * 65536, 256, 256, 256, ((int)blockIdx.x + G - 8 * gi) % G, G, [=](int row, int col, float v) {
            const int cc = gi * 256 + col; const float gc = bf2f(Z1[(size_t)(MP + row) * NIN_O + 1024 + cc]);
            Y[(size_t)(MP + row) * 2048 + cc] = (bf16_t)f2bf(v * ps[cc] * gc); });
    for (int it = G - 1 - (int)blockIdx.x; it < 128; it += G) ret_sample_item(p, lds, it);
    const bf16_t* KVC = (const bf16_t*)(p.ws + WS_KVC); bf16_t* BSV = (bf16_t*)(p.ws + WS_BSV);
    for (int it = blockIdx.x * NTHREADS + tid; it < 16 * 8192; it += G * NTHREADS) {
        const int bh = it >> 13, e = (it & 8191) * 8, dv = e >> 8, dk0 = e & 255;
        const float g256 = exp2f(256.0f * ret_log2g(bh & 3));
        float s[8];
#pragma unroll
        for (int k = 0; k < 8; ++k) s[k] = 0.f;
#pragma unroll
        for (int c = 0; c < 16; ++c) {
            const size_t u = (size_t)(bh * 16 + c);
            float kv[8]; unpack8(__builtin_nontemporal_load((const u32x4*)(KVC + u * 65536 + e)), kv);
            *(u32x4*)(BSV + (u * 256 + dv) * 512 + dk0) = pack8(s);
#pragma unroll
            for (int k = 0; k < 8; ++k) s[k] = g256 * s[k] + kv[k];
        }
        float* o = p.out + O_RETP + (size_t)bh * 65536 + (size_t)dk0 * 256 + dv;
#pragma unroll
        for (int k = 0; k < 8; ++k) __builtin_nontemporal_store(s[k], o + (size_t)k * 256);
    }
}

struct EpiRet {
    static constexpr bool PERM = true;
    const bf16_t* Z1; bf16_t* Y; LAS float* X;
    DI void operator()(const f32x4 (&acc)[2][2][4][2], const pg8::Unit& u, int wr, int wc, int fr, int fq) const {
        const int b = u.pm >> 6, h = (u.pm >> 4) & 3, cc = u.pm & 15;
#pragma unroll
        for (int ai = 0; ai < 2; ++ai)
#pragma unroll
            for (int m = 0; m < 4; ++m) { float ss = 0.f;
#pragma unroll
                for (int bj = 0; bj < 2; ++bj)
#pragma unroll
                    for (int n = 0; n < 2; ++n) { const f32x4 v = acc[ai][bj][m][n]; ss += (v[0] * v[0] + v[1] * v[1]) + (v[2] * v[2] + v[3] * v[3]); }
                ss += __shfl_xor(ss, 16); ss += __shfl_xor(ss, 32);
                if (fq == 0) X[(ai * 128 + wr * 64 + m * 16 + fr) * 4 + wc] = ss; }
        asm volatile("s_waitcnt lgkmcnt(0)" ::: "memory"); __builtin_amdgcn_s_barrier(); asm volatile("" ::: "memory");
        const size_t rowbase = (size_t)b * SEQ + cc * 256;
#pragma unroll
        for (int ai = 0; ai < 2; ++ai)
#pragma unroll
            for (int m = 0; m < 4; ++m) { const int i = ai * 128 + wr * 64 + m * 16 + fr;
                const f32x4 xs = *(const LAS f32x4*)(X + i * 4);
                const float rstd = rsqrtf(((xs[0] + xs[1]) + (xs[2] + xs[3])) * (1.0f / 256.0f) + EPS);
#pragma unroll
                for (int bj = 0; bj < 2; ++bj) { const int col = wc * 32 + 8 * fq + bj * 128; const f32x4 v0 = acc[ai][bj][m][0], v1 = acc[ai][bj][m][1];
                    float gd[8], y[8]; unpack8(__builtin_nontemporal_load((const u32x4*)(Z1 + (rowbase + i) * NIN_O + 5120 + h * 256 + col)), gd);
#pragma unroll
                    for (int k = 0; k < 4; ++k) { y[k] = v0[k] * rstd * gd[k]; y[4 + k] = v1[k] * rstd * gd[4 + k]; }
                    *(u32x4*)(Y + (rowbase + i) * 2048 + 1024 + h * 256 + col) = pack8(y); }
                asm volatile("" ::: "memory"); }
        asm volatile("s_waitcnt lgkmcnt(0)" ::: "memory"); __builtin_amdgcn_s_barrier(); asm volatile("" ::: "memory");
    }
};
DI void ret_sample_item(const Params& p, LAS unsigned char* ldsb, int item) {
    const int tid = ltid(), wid = tid >> 6, lane = tid & 63;
    const int b = item >> 2, h = item & 3;
    LAS float* qs = (LAS float*)ldsb; LAS float* ks = qs + 256; LAS float* vs = qs + 512; LAS float* red = qs + 768; LAS float* misc = qs + 768 + 2048;
    const bf16_t* zr = (const bf16_t*)(p.ws + WS_Z) + (size_t)(MP + b) * NIN_O;
    if (tid < 256) { qs[tid] = bf2f(zr[2048 + h * 256 + tid]); ks[tid] = bf2f(zr[3072 + h * 256 + tid]); vs[tid] = bf2f(zr[4096 + h * 256 + tid]); }
    __syncthreads();
    float sp = 0.f;
#pragma unroll
    for (int i = 0; i < 4; ++i) sp += qs[lane + 64 * i] * ks[lane + 64 * i];
    const float score = wave_sum(sp);
    const float g = 1.0f - exp2f(-5.0f - (float)h);
    const float* sin = p.in[8] + (size_t)(b * 4 + h) * 65536; float* sout = p.out + O_RETS + (size_t)(b * 4 + h) * 65536;
    const int dv4 = lane * 4;
    const f32x4 v4 = *(const LAS f32x4*)(vs + dv4);
    f32x4 cr = (f32x4){0.f, 0.f, 0.f, 0.f};
#pragma unroll 8
    for (int i = 0; i < 32; ++i) { const int dk = wid + 8 * i; const f32x4 s4 = __builtin_nontemporal_load((const f32x4*)(sin + (size_t)dk * 256 + dv4));
        cr += s4 * qs[dk]; __builtin_nontemporal_store(s4 * g + v4 * ks[dk], (f32x4*)(sout + (size_t)dk * 256 + dv4)); }
    *(LAS f32x4*)(red + wid * 256 + dv4) = cr;
    __syncthreads();
    float o = 0.f;
    if (tid < 256) { float cs = 0.f;
#pragma unroll
        for (int w = 0; w < 8; ++w) cs += red[w * 256 + tid];
        o = score * vs[tid] + cs * g; }
    const float ssw = wave_sum(o * o);
    if (lane == 0) misc[wid] = ssw;
    __syncthreads();
    if (tid < 256) { const float ss = misc[0] + misc[1] + misc[2] + misc[3]; const float rstd = rsqrtf(ss * (1.0f / 256.0f) + EPS);
        const float gd = bf2f(zr[5120 + h * 256 + tid]);
        ((bf16_t*)(p.ws + WS_Y))[(size_t)(MP + b) * 2048 + 1024 + h * 256 + tid] = (bf16_t)f2bf(o * rstd * gd); }
    __syncthreads();
}
DI void phase9(const Params& p, LAS unsigned char* lds) {
    const int G = gridDim.x;
    {
        pg8::Gemm g{(const bf16_t*)(p.ws + WS_AQP), (const bf16_t*)(p.ws + WS_BSV), 512, 512, 512}; RetOrder S{G, (int)blockIdx.x, 2};
        EpiRet E{(const bf16_t*)(p.ws + WS_Z), (bf16_t*)(p.ws + WS_Y), (LAS float*)(lds + 131072 + 1024)};
        pg8::gemm_phase<EpiRet, RetOrder>(lds, g, S, E);
    }
}

DI void final_norm(const Params& p) {
    const int tid = ltid(), wid = tid >> 6, lane = tid & 63, G = gridDim.x;
    const int gw = blockIdx.x * NWAVES + wid, NGW = G * NWAVES;
    const bf16_t* X = (const bf16_t*)(p.ws + WS_X1); const float* gn = p.in[23];
    for (int m0 = gw * 2; m0 < MT; m0 += NGW * 2) {
        f32x4 v[2][4]; float ss[2];
#pragma unroll
        for (int rr = 0; rr < 2; ++rr) { const bf16_t* xrow = X + (size_t)(m0 + rr) * DM; ss[rr] = 0.f;
#pragma unroll
            for (int j = 0; j < 4; ++j) v[rr][j] = ld4bf(xrow + 4 * lane + 256 * j); }
#pragma unroll
        for (int rr = 0; rr < 2; ++rr) {
#pragma unroll
            for (int j = 0; j < 4; ++j) ss[rr] += (v[rr][j].x * v[rr][j].x + v[rr][j].y * v[rr][j].y) + (v[rr][j].z * v[rr][j].z + v[rr][j].w * v[rr][j].w); }
#pragma unroll
        for (int rr = 0; rr < 2; ++rr) { const int m = m0 + rr; float* orow = m < MP ? p.out + O_YP + (size_t)m * DM : p.out + O_YS + (size_t)(m - MP) * DM;
            const float rstd = rsqrtf(wave_sum(ss[rr]) * (1.f / DM) + EPS);
#pragma unroll
            for (int j = 0; j < 4; ++j) { const int col = 4 * lane + 256 * j; __builtin_nontemporal_store(v[rr][j] * rstd * *(const f32x4*)(gn + col), (f32x4*)(orow + col)); } }
    }
}

#define XB_TMO      128
#define XB_XCNT(j)  (256  + 64 * (j))
#define XB_XSUB(j)  (1280 + 64 * (j))
#define XB_XGEN(j)  (2304 + 64 * (j))
#define XB_TOP      3328
#define XB_TOPGEN   3392
#define XCD_BAR_WORDS 3456
#define XB_SPIN_CAP (1u << 22)
DI unsigned xb_ld(unsigned* p)              { return __hip_atomic_load(p, __ATOMIC_RELAXED, __HIP_MEMORY_SCOPE_AGENT); }
DI unsigned xb_add(unsigned* p, unsigned v) { return __hip_atomic_fetch_add(p, v, __ATOMIC_RELAXED, __HIP_MEMORY_SCOPE_AGENT); }
DI unsigned xb_xcc_id() { return (unsigned)__builtin_amdgcn_s_getreg((3 << 11) | 20) & 0xFu; }
#define XB_SPIN(cond, bar) do { unsigned _sp = 0; while (cond) { __builtin_amdgcn_s_sleep(1); \
    if ((++_sp & 255u) == 0u) { if (xb_ld(&(bar)[XB_TMO])) break; if (_sp > XB_SPIN_CAP) { atomicAdd(&(bar)[XB_TMO], 1u); break; } } } } while (0)
struct XcdBarrier { unsigned* bar; unsigned x; volatile LAS unsigned* st; };
DI XcdBarrier xcd_barrier_post(unsigned* bar, volatile LAS unsigned* st) {
    XcdBarrier b; b.bar = bar; b.x = xb_xcc_id(); b.st = st;
    if (threadIdx.x == 0) (void)xb_add(&bar[XB_XCNT(b.x)], 1u);
    return b;
}
DI void xcd_barrier_complete(unsigned* bar, unsigned x, unsigned& nloc, unsigned& nx) {
    const unsigned G = gridDim.x * gridDim.y * gridDim.z;
    unsigned sum, cnt, mine, sp = 0u;
    for (;;) {
        sum = 0u; cnt = 0u; mine = 0u;
#pragma unroll
        for (unsigned j = 0; j < 16; ++j) { const unsigned c = xb_ld(&bar[XB_XCNT(j)]); sum += c; cnt += (c > 0u) ? 1u : 0u; mine = (j == x) ? c : mine; }
        if (sum == G) break;
        __builtin_amdgcn_s_sleep(1);
        if ((++sp & 255u) == 0u) { if (xb_ld(&bar[XB_TMO])) break; if (sp > XB_SPIN_CAP) { atomicAdd(&bar[XB_TMO], 1u); break; } }
    }
    nloc = mine > 0u ? mine : 1u; nx = cnt > 0u ? cnt : 1u;
}
DI void xcd_barrier(const XcdBarrier& b) {
    asm volatile("s_waitcnt vmcnt(0)" ::: "memory");
    __syncthreads();
    if (threadIdx.x == 0) {
        unsigned* bar = b.bar;
        __builtin_amdgcn_s_waitcnt(0);
        unsigned nloc = b.st[0], nx = b.st[1];
        if (nloc == 0u) { xcd_barrier_complete(bar, b.x, nloc, nx); b.st[0] = nloc; b.st[1] = nx; }
        const unsigned old = xb_add(&bar[XB_XSUB(b.x)], 1u);
        const unsigned gen = old / nloc;
        if (old + 1u == (gen + 1u) * nloc) {
            __builtin_amdgcn_fence(__ATOMIC_RELEASE, "agent");
            asm volatile("s_waitcnt vmcnt(0)" ::: "memory");
            const unsigned og = xb_add(&bar[XB_TOP], 1u);
            const unsigned tg = og / nx;
            if (og + 1u == (tg + 1u) * nx) xb_add(&bar[XB_TOPGEN], 1u);
            else XB_SPIN(xb_ld(&bar[XB_TOPGEN]) == tg, bar);
            __builtin_amdgcn_fence(__ATOMIC_ACQUIRE, "agent");
            xb_add(&bar[XB_XGEN(b.x)], 1u);
            asm volatile("s_waitcnt vmcnt(0)" ::: "memory");
        } else {
            XB_SPIN(xb_ld(&bar[XB_XGEN(b.x)]) == gen, bar);
            __builtin_amdgcn_fence(__ATOMIC_ACQUIRE, "agent");
            asm volatile("s_waitcnt vmcnt(0)" ::: "memory");
        }
    }
    __syncthreads();
}

#ifndef ONLYP
#define ONLYP -1
#endif
#ifndef SKIPP
#define SKIPP -2
#endif
#define PH(k) ((ONLYP < 0 || ONLYP == (k)) && SKIPP != (k))
#ifndef REPP
#define REPP -3
#endif

#ifndef REPQ
#define REPQ -3
#endif
#define RP(k, call) do { if (PH(k)) { call; if (REPP == (k) || REPQ == (k)) { GSYNC(); call; } } } while (0)
__global__ void __launch_bounds__(NTHREADS, 2) fwd_megakernel(Params p) {
    extern __shared__ __attribute__((aligned(16))) unsigned char lds_raw[];
    LAS unsigned char* lds = (LAS unsigned char*)lds_raw;
    cg::grid_group grid = cg::this_grid();
    volatile LAS unsigned* bst = (volatile LAS unsigned*)(lds + LDS_BYTES - 16);
    if (threadIdx.x < 2) bst[threadIdx.x] = 0u;
    __syncthreads();
    const XcdBarrier xbar = xcd_barrier_post((unsigned*)(p.ws + WS_BAR), bst);
#define GSYNC() xcd_barrier(xbar)
    if (p.ws == nullptr) grid.sync();
    RP(0, phase0(p, lds));
    {
        if (ltid() < 64) { unsigned spins = 0; unsigned* mc = (unsigned*)(p.ws + WS_BAR) + XCNT_WORD + 160;
            while ((unsigned)__builtin_amdgcn_readfirstlane(__hip_atomic_load(mc, __ATOMIC_RELAXED, __HIP_MEMORY_SCOPE_AGENT)) < 192u && ++spins < (1u << 22)) __builtin_amdgcn_s_sleep(2);
            __builtin_amdgcn_fence(__ATOMIC_ACQUIRE, "agent"); }
        asm volatile("s_waitcnt vmcnt(0) lgkmcnt(0)" ::: "memory");
        __syncthreads();
    }
    RP(1, h_rows<false>(p, 0, p.in[0], p.in[1]));
    GSYNC();
    RP(2, phase2(p, lds));
    GSYNC();
    RP(3, phase3(p, lds));
    GSYNC();
    if (gridDim.x == 256) { if (PH(4)) phase_out_mid(p, lds); GSYNC(); }
    else { RP(4, phase_out(p, lds, 0)); GSYNC(); RP(5, h_rows<true>(p, 1, (const bf16_t*)(p.ws + WS_X1), (const bf16_t*)(p.ws + WS_X1) + (size_t)MP * DM)); GSYNC(); }
    RP(6, phase6(p, lds));
    GSYNC();
    RP(7, phase7(p, lds));
    GSYNC();
    RP(8, phase8(p, lds));
    GSYNC();
    RP(9, phase9(p, lds));
    GSYNC();
    if (gridDim.x == 256) { if (PH(10)) phase_out_final(p, lds); }
    else { RP(10, phase_out(p, lds, 1)); GSYNC(); RP(11, final_norm(p)); }
}

extern "C" void kernel_launch(void* const* d_in, const int* in_sizes, int n_in, void* d_out, int out_size, void* d_ws, size_t ws_size, hipStream_t stream) {
    static int grid = 0;
    if (grid == 0) {
        if (n_in != 24 || (size_t)out_size != O_END || ws_size < WS_END) { fprintf(stderr, "kernel_launch: unexpected shapes: n_in %d out %d ws %zu\n", n_in, out_size, ws_size); grid = -1; return; }
        int dev = 0, cus = 0, per_cu = 0;
        if (hipGetDevice(&dev) != hipSuccess || hipDeviceGetAttribute(&cus, hipDeviceAttributeMultiprocessorCount, dev) != hipSuccess) { grid = -1; return; }
        if (hipFuncSetAttribute((const void*)fwd_megakernel, hipFuncAttributeMaxDynamicSharedMemorySize, LDS_BYTES) != hipSuccess) { fprintf(stderr, "kernel_launch: hipFuncSetAttribute failed\n"); grid = -1; return; }
        if (hipOccupancyMaxActiveBlocksPerMultiprocessor(&per_cu, (const void*)fwd_megakernel, NTHREADS, LDS_BYTES) != hipSuccess || per_cu < 1) { fprintf(stderr, "kernel_launch: occupancy query says %d\n", per_cu); per_cu = 1; }
        (void)hipGetLastError();
        grid = cus;
    }
    if (grid < 0) return;
    if (hipMemsetAsync((char*)d_ws + WS_BAR, 0, 16384, stream) != hipSuccess) { fprintf(stderr, "kernel_launch: memset failed\n"); return; }
    Params p{};
    for (int i = 0; i < 24; ++i) p.in[i] = (const float*)d_in[i];
    p.out = (float*)d_out; p.ws = (unsigned char*)d_ws;
    void* args[] = {&p};
    hipError_t e = hipLaunchCooperativeKernel((const void*)fwd_megakernel, dim3(grid), dim3(NTHREADS), args, LDS_BYTES, stream);
    if (e != hipSuccess) fprintf(stderr, "cooperative launch failed: %s (grid %d)\n", hipGetErrorString(e), grid);
}
```

```cpp
#include <hip/hip_runtime.h>
#include <hip/hip_cooperative_groups.h>
#include <cstdio>
#include <cstdint>
namespace cg = cooperative_groups;
#ifndef SUBP
#define SUBP -1
#endif
#define SUB(id, ...) do { __VA_ARGS__; if (SUBP == (id)) { __syncthreads(); __VA_ARGS__; } } while (0)

#define LAS __attribute__((address_space(3)))
#define DI __device__ __forceinline__
typedef unsigned short bf16_t;
typedef short bf16x8 __attribute__((ext_vector_type(8)));
typedef short s16x4 __attribute__((ext_vector_type(4)));
typedef float f32x4 __attribute__((ext_vector_type(4)));
typedef float f32x16 __attribute__((ext_vector_type(16)));
typedef unsigned u32x4 __attribute__((ext_vector_type(4)));
typedef unsigned u32x2 __attribute__((ext_vector_type(2)));

constexpr int DM = 1024, SEQ = 4096, NB = 4, MP = NB * SEQ  , NS = 32  , MT = MP + NS;
constexpr int NIN_E = 8192, NIN_O = 6144;
constexpr int ZLD = NIN_E + 128;
constexpr float EPS = 1e-6f, LOG2E = 1.4426950408889634f;
constexpr size_t O_YP = 0, O_YS = 16777216, O_CONVP = 16809984, O_CONVS = 16818176, O_KP = 16883712, O_KS = 25272320, O_VP = 25305088,
                 O_VS = 33693696, O_POOLP = 33726464, O_POOLS = 33787904, O_RETP = 34279424, O_RETS = 35328000, O_END = 43716608;
constexpr size_t MiB = 1u << 20;
constexpr size_t WS_XSLOT = 1 * MiB + 65536  ;
constexpr int XCNT_WORD = 3600  ;
constexpr size_t WS_BAR = 1 * MiB  ;
constexpr size_t WS_MOD = 0, WS_WINE = 2 * MiB, WS_WOUTE = 18 * MiB, WS_WINO = 22 * MiB, WS_WOUTO = 34 * MiB, WS_PWT = 38 * MiB,
                 WS_H = 40 * MiB, WS_Y = 74 * MiB, WS_X1 = 140 * MiB, WS_POOLED = 206 * MiB, WS_Z = 240 * MiB, WS_KT = 434 * MiB, WS_VT = 466 * MiB,
                 WS_KVC = 500 * MiB, WS_AQP = 564 * MiB, WS_BSV = 628 * MiB, WS_END = 692 * MiB;
constexpr int LDS_BYTES = 147456;
constexpr int NWAVES = 8, NTHREADS = 512;

struct Params { const float* in[24]; float* out; unsigned char* ws; };

DI int ltid() { int t = threadIdx.x; asm volatile("" : "+v"(t)); return t; }
DI unsigned f2bf(float f) { unsigned u = __builtin_bit_cast(unsigned, f); return (u + 0x7fffu + ((u >> 16) & 1u)) >> 16; }
DI unsigned pk2(float lo, float hi) { unsigned r; asm("v_cvt_pk_bf16_f32 %0, %1, %2" : "=v"(r) : "v"(lo), "v"(hi)); return r; }
DI float bflo(unsigned w) { return __builtin_bit_cast(float, w << 16); }
DI float bfhi(unsigned w) { return __builtin_bit_cast(float, w & 0xffff0000u); }
DI float bf2f(bf16_t b) { return __builtin_bit_cast(float, (unsigned)b << 16); }
DI f32x4 ld4bf(const bf16_t* p) { const u32x2 w = *(const u32x2*)p; return (f32x4){bflo(w.x), bfhi(w.x), bflo(w.y), bfhi(w.y)}; }
DI float silu(float x) { return x / (1.0f + __expf(-x)); }
DI float wave_sum(float v) {
#pragma unroll
    for (int o = 1; o < 64; o <<= 1) v += __shfl_xor(v, o);
    return v;
}
DI float wave_max(float v) {
#pragma unroll
    for (int o = 1; o < 64; o <<= 1) v = fmaxf(v, __shfl_xor(v, o));
    return v;
}

namespace pg8 {
constexpr int BM = 256, BK = 64, HALF = 128, HTB = HALF * BK * 2, STAGE_BYTES = 8 * HTB, NXCD = 8, WGM = 4;
DI int lds_byte(int r, int c) { const int st = (r >> 4) * 2 + (c >> 5), rr = r & 15, cc = c & 31, ob = rr * 64 + cc * 2; return st * 1024 + (ob ^ (((ob >> 9) & 1) << 5)); }
DI void stage_rc(int b, int& R, int& C) { const int st = b / 1024, sb = b % 1024, swz = sb ^ (((sb >> 9) & 1) << 5); R = (st >> 1) * 16 + swz / 64; C = (st & 1) * 32 + (swz % 64) / 2; }
DI int perm32(int rho) { const int n = rho >> 4, i = rho & 15; return 8 * (i >> 2) + 4 * n + (i & 3); }
struct Unit { int pm, pn; };
struct Gemm { const bf16_t* A; const bf16_t* Bt; int lda, ldb, K; };

struct StaticOrder {
    int nM, nN, nwg, G, c; size_t tA, tB, aPn;
    DI void init(int M, int N, int G_, int c_, int lda, int ldb, size_t aPn_ = 0) { nM = M / BM; nN = N / BM; nwg = nM * nN; G = G_; c = c_; tA = (size_t)BM * lda * 2; tB = (size_t)BM * ldb * 2; aPn = aPn_; }
    DI bool next(int i, Unit& u) const {
        const long L = (long)i * G + c; if (L >= nwg) return false;
        int wgid = (int)L; { const int q = nwg / NXCD, r = nwg % NXCD, xcd = wgid % NXCD, off = wgid / NXCD; wgid = (xcd < r ? xcd * (q + 1) : r * (q + 1) + (xcd - r) * q) + off; }
        const int nig = WGM * nN, gid = wgid / nig, fm = gid * WGM, gsz = (nM - fm) < WGM ? (nM - fm) : WGM;
        u.pm = fm + ((wgid % nig) % gsz); u.pn = (wgid % nig) / gsz; return true;
    }
    DI size_t offA(const Unit& u) const { return (size_t)u.pm * tA + (size_t)u.pn * aPn; }
    DI size_t offB(const Unit& u) const { return (size_t)u.pn * tB; }
};

DI unsigned cvt_pk_bf16(float lo, float hi) { unsigned r; asm volatile("v_cvt_pk_bf16_f32 %0, %1, %2" : "=v"(r) : "v"(lo), "v"(hi)); return r; }

template <class Epi, class Sched, bool ALIGN_EPI = true, bool SP2 = true>
DI void gemm_phase(LAS unsigned char* lds, const Gemm g, const Sched& S, const Epi& E) {
    const int tid = ltid(), wid = __builtin_amdgcn_readfirstlane(tid >> 6), lane = tid & 63, wr = wid >> 2, wc = wid & 3, fr = lane & 15, fq = lane >> 4;
    const int K = g.K, nt = K / BK;
    unsigned voffA[2], voffB[2];
#pragma unroll
    for (int i = 0; i < 2; ++i) { int R, C; stage_rc(tid * 16 + i * 8192, R, C); const int Rb = Epi::PERM ? ((R & ~31) + perm32(R & 31)) : R;
        voffA[i] = (unsigned)(R * g.lda + C) * 2u; voffB[i] = (unsigned)(Rb * g.ldb + C) * 2u; }
    const size_t kstep = (size_t)(BK * 2);
    const size_t hstepA = (size_t)HALF * g.lda * 2, hstepB = (size_t)HALF * g.ldb * 2;
    const unsigned ldsw = (unsigned)wid * 1024u;
    const int aoff = lds_byte(wr * 64 + fr, fq * 8), boff = lds_byte(wc * 32 + fr, fq * 8);
#define PG8_SA(b, h) (((b) * 2 + (h)) * HTB)
#define PG8_SB(b, h) ((4 + (b) * 2 + (h)) * HTB)
#define PG8_STAGE(bufoff, gbase, voff) do { _Pragma("unroll") for (int _i = 0; _i < 2; ++_i) \
        __builtin_amdgcn_global_load_lds((const unsigned*)((const char*)(gbase) + (voff)[_i]), (LAS unsigned*)(lds + (bufoff) + ldsw + _i * 8192), 16, 0, 0); } while (0)
#define PG8_LDA(dst, b, h) do { _Pragma("unroll") for (int m = 0; m < 4; ++m) _Pragma("unroll") for (int k = 0; k < 2; ++k) dst[m][k] = *(const LAS bf16x8*)(lds + PG8_SA(b, h) + aoff + m * 2048 + k * 1024); } while (0)
#define PG8_LDB(dst, b, h) do { _Pragma("unroll") for (int n = 0; n < 2; ++n) _Pragma("unroll") for (int k = 0; k < 2; ++k) dst[n][k] = *(const LAS bf16x8*)(lds + PG8_SB(b, h) + boff + n * 2048 + k * 1024); } while (0)
#define PG8_MMA(ai, bj, At, Bt) do { __builtin_amdgcn_s_setprio(1); _Pragma("unroll") for (int m = 0; m < 4; ++m) _Pragma("unroll") for (int n = 0; n < 2; ++n) _Pragma("unroll") for (int k = 0; k < 2; ++k) \
        acc[ai][bj][m][n] = __builtin_amdgcn_mfma_f32_16x16x32_bf16(Bt[n][k], At[m][k], acc[ai][bj][m][n], 0, 0, 0); __builtin_amdgcn_s_setprio(0); } while (0)
#define PG8_WAIT_V(n) asm volatile("s_waitcnt vmcnt(" #n ")" ::: "memory")
#define PG8_WAIT_L(n) asm volatile("s_waitcnt lgkmcnt(" #n ")" ::: "memory")
#define PG8_BAR __builtin_amdgcn_s_barrier()
#define PG8_SCHED __builtin_amdgcn_sched_barrier(0)
    Unit cur, nxt; int ui = 0;
    if (!S.next(0, cur)) return;
    f32x4 acc[2][2][4][2];
#pragma unroll
    for (int a = 0; a < 2; ++a)
#pragma unroll
        for (int b = 0; b < 2; ++b)
#pragma unroll
            for (int m = 0; m < 4; ++m)
#pragma unroll
                for (int n = 0; n < 2; ++n) acc[a][b][m][n] = (f32x4){0.f, 0.f, 0.f, 0.f};
    bf16x8 At[4][2], B0[2][2], B1[2][2];
    const char* cA = (const char*)g.A + S.offA(cur); const char* cB = (const char*)g.Bt + S.offB(cur);
    if constexpr (SP2) {
        PG8_STAGE(PG8_SB(0, 0), cB, voffB); PG8_STAGE(PG8_SB(0, 1), cB + hstepB, voffB); PG8_STAGE(PG8_SA(0, 0), cA, voffA); PG8_STAGE(PG8_SA(0, 1), cA + hstepA, voffA);
        if (wr == 1) PG8_BAR;
        PG8_WAIT_V(2); PG8_BAR;
        PG8_STAGE(PG8_SB(1, 0), cB + kstep, voffB); PG8_STAGE(PG8_SA(1, 0), cA + kstep, voffA); PG8_STAGE(PG8_SB(1, 1), cB + hstepB + kstep, voffB);
        PG8_WAIT_V(6); PG8_BAR;
    }
    for (;;) {
        const bool has_next = S.next(ui + 1, nxt);
        const char* nA = has_next ? (const char*)g.A + S.offA(nxt) : cA; const char* nB = has_next ? (const char*)g.Bt + S.offB(nxt) : cB;
#pragma unroll 1
        for (int t = 0; t < nt; t += 2) {
            const bool last = (t == nt - 2);
            const char* a1 = cA + (size_t)(t + 1) * kstep;
            const char* a2 = last ? nA : cA + (size_t)(t + 2) * kstep; const char* b2 = last ? nB : cB + (size_t)(t + 2) * kstep;
            const char* a3 = a2 + kstep; const char* b3 = b2 + kstep;
            PG8_LDB(B0, 0, 0); PG8_LDB(B1, 0, 1); PG8_SCHED; PG8_LDA(At, 0, 0); PG8_STAGE(PG8_SA(1, 1), a1 + hstepA, voffA);
            PG8_WAIT_V(8); PG8_WAIT_L(0); PG8_BAR; PG8_MMA(0, 0, At, B0); PG8_MMA(0, 1, At, B1); PG8_BAR; PG8_SCHED;
            PG8_LDA(At, 0, 1); PG8_STAGE(PG8_SB(0, 0), b2, voffB); PG8_STAGE(PG8_SB(0, 1), b2 + hstepB, voffB); PG8_STAGE(PG8_SA(0, 0), a2, voffA);
            PG8_WAIT_V(8); PG8_WAIT_L(0); PG8_BAR; PG8_MMA(1, 0, At, B0); PG8_MMA(1, 1, At, B1); PG8_BAR; PG8_SCHED;
            PG8_LDB(B0, 1, 0); PG8_LDB(B1, 1, 1); PG8_SCHED; PG8_LDA(At, 1, 0); PG8_STAGE(PG8_SA(0, 1), a2 + hstepA, voffA);
            PG8_WAIT_V(8); PG8_WAIT_L(0); PG8_BAR; PG8_MMA(0, 0, At, B0); PG8_MMA(0, 1, At, B1); PG8_BAR; PG8_SCHED;
            PG8_LDA(At, 1, 1); PG8_STAGE(PG8_SB(1, 0), b3, voffB); PG8_STAGE(PG8_SB(1, 1), b3 + hstepB, voffB); PG8_STAGE(PG8_SA(1, 0), a3, voffA);
            PG8_WAIT_V(8); PG8_WAIT_L(0); PG8_BAR; PG8_MMA(1, 0, At, B0); PG8_MMA(1, 1, At, B1); PG8_BAR; PG8_SCHED;
        }
        if constexpr (ALIGN_EPI) { if (wr == 0) PG8_BAR; }
        E(acc, cur, wr, wc, fr, fq);
        if (!has_next) break;
#pragma unroll
        for (int a = 0; a < 2; ++a)
#pragma unroll
            for (int b = 0; b < 2; ++b)
#pragma unroll
                for (int m = 0; m < 4; ++m)
#pragma unroll
                    for (int n = 0; n < 2; ++n) acc[a][b][m][n] = (f32x4){0.f, 0.f, 0.f, 0.f};
        cur = nxt; cA = nA; cB = nB; ++ui;
        if constexpr (ALIGN_EPI) { if (wr == 1) PG8_BAR; }
    }
    PG8_WAIT_V(0);
    if constexpr (!ALIGN_EPI) { if (wr == 0) PG8_BAR; }
    PG8_BAR;
#undef PG8_SA
#undef PG8_SB
#undef PG8_STAGE
#undef PG8_LDA
#undef PG8_LDB
#undef PG8_MMA
#undef PG8_WAIT_V
#undef PG8_WAIT_L
#undef PG8_BAR
#undef PG8_SCHED
}
}

DI int crow32(int reg, int h) { return (reg & 3) + 8 * (reg >> 2) + 4 * h; }
template <class F>
DI void small_gemm(LAS unsigned char* lds, const bf16_t* A, int lda, const bf16_t* Wt, int ldb, int K, int N, int tile0, int tstride, F f) {
    const int tid = ltid(), wid = tid >> 6, lane = tid & 63, r = lane & 31, h = lane >> 5;
    LAS float* red = (LAS float*)lds;
    const int kw = K / 8;
    for (int tile = tile0; tile < N / 32; tile += tstride) {
        const int n0 = tile * 32;
        f32x16 acc;
#pragma unroll
        for (int i = 0; i < 16; ++i) acc[i] = 0.f;
        const bf16_t* ap = A + (size_t)r * lda + wid * kw + 8 * h;
        const bf16_t* bp = Wt + (size_t)(n0 + r) * ldb + wid * kw + 8 * h;
#pragma unroll 8
        for (int ks = 0; ks < kw; ks += 16) {
            const bf16x8 a = *(const bf16x8*)(ap + ks), b = *(const bf16x8*)(bp + ks);
            acc = __builtin_amdgcn_mfma_f32_32x32x16_bf16(a, b, acc, 0, 0, 0);
        }
#pragma unroll
        for (int i = 0; i < 16; ++i) red[wid * 1024 + i * 64 + lane] = acc[i];
        __syncthreads();
        for (int e = tid; e < 1024; e += NTHREADS) {
            float s = 0.f;
#pragma unroll
            for (int w = 0; w < 8; ++w) s += red[w * 1024 + e];
            const int i = e >> 6, ln = e & 63;
            f(crow32(i, ln >> 5), n0 + (ln & 31), s);
        }
        __syncthreads();
    }
}

DI int rowmap_e(int n) { if (n >= 4096) return n; const int which = n >> 10, tile = (n & 1023) >> 6, chl = n & 63; return tile * 256 + 128 * (which >> 1) + 32 * (chl >> 4) + 8 * ((chl >> 2) & 3) + (which & 1) * 4 + (chl & 3); }
DI int colmap_e(int r) { if (r >= 4096) return r; const int tile = r >> 8, cidx = r & 255, bj = cidx >> 7, wc = (cidx >> 5) & 3, fq = (cidx >> 3) & 3, e = cidx & 7; return (2 * bj + (e >> 2)) * 1024 + tile * 64 + 16 * wc + 4 * fq + (e & 3); }
DI void p0_transpose_item(const float* W, int K, int N, bf16_t* WT, LAS float* scr, int item, int lane, bool perm_e = false) {
    const int nblk = N / 32, kb = item / nblk, nb = item % nblk, k0 = 64 * kb, n0 = 32 * nb;
    float tv[32];
#pragma unroll
    for (int i = 0; i < 32; ++i) tv[i] = __builtin_nontemporal_load(W + (size_t)(k0 + 2 * i + (lane >> 5)) * N + n0 + (lane & 31));
#pragma unroll
    for (int i = 0; i < 32; ++i) scr[(2 * i + (lane >> 5)) * 33 + (lane & 31)] = tv[i];
    asm volatile("s_waitcnt lgkmcnt(0)" ::: "memory");
    const int c = lane & 7;
#pragma unroll
    for (int j = 0; j < 4; ++j) { const int n = (lane >> 3) + 8 * j; const LAS float* s = scr + (8 * c) * 33 + n;
        u32x4 o; o.x = pk2(s[0 * 33], s[1 * 33]); o.y = pk2(s[2 * 33], s[3 * 33]); o.z = pk2(s[4 * 33], s[5 * 33]); o.w = pk2(s[6 * 33], s[7 * 33]);
        *(u32x4*)(WT + (size_t)(perm_e ? rowmap_e(n0 + n) : (n0 + n)) * K + k0 + 8 * c) = o; }
    asm volatile("s_waitcnt lgkmcnt(0)" ::: "memory");
}

DI void p0_mod_unit(const Params& p, int u, LAS unsigned char* ldsb) {
    LAS float* lds = (LAS float*)ldsb;
    const int tid = ltid(), wid = tid >> 6, lane = tid & 63;
    const int l = u / 96, rem = u % 96, nb = rem >> 1, bh = rem & 1;
    const float* aw = l ? p.in[17] : p.in[10]; const float* ab = l ? p.in[18] : p.in[11];
    float* MOD = (float*)(p.ws + WS_MOD);
    for (int idx = tid; idx < 18 * 1024; idx += NTHREADS) { const int i = idx >> 10, k = idx & 1023, bi = bh * 18 + i;
        const float c = bi < 4 ? p.in[2][bi * 1024 + k] : p.in[3][(bi - 4) * 1024 + k]; lds[idx] = silu(c); }
    __syncthreads();
    float acc[18];
#pragma unroll
    for (int i = 0; i < 18; ++i) acc[i] = 0.f;
    const int n = nb * 64 + lane;
    const float* wp = aw + (size_t)(wid * 128) * 3072 + n;
#pragma unroll 2
    for (int k = 0; k < 128; k += 4) {
        const float w0 = wp[(size_t)(k + 0) * 3072], w1 = wp[(size_t)(k + 1) * 3072], w2 = wp[(size_t)(k + 2) * 3072], w3 = wp[(size_t)(k + 3) * 3072];
#pragma unroll
        for (int i = 0; i < 18; ++i) { const f32x4 s = *(const LAS f32x4*)(lds + i * 1024 + wid * 128 + k); acc[i] += s.x * w0 + s.y * w1 + s.z * w2 + s.w * w3; }
    }
    __syncthreads();
#pragma unroll
    for (int i = 0; i < 18; ++i) lds[(wid * 18 + i) * 64 + lane] = acc[i];
    __syncthreads();
    for (int o = tid; o < 18 * 64; o += NTHREADS) { const int i = o >> 6, ln = o & 63; float s = 0.f;
#pragma unroll
        for (int w = 0; w < 8; ++w) s += lds[(w * 18 + i) * 64 + ln];
        const int nn = nb * 64 + ln; MOD[(size_t)(l * 36 + bh * 18 + i) * 3072 + nn] = s + ab[nn]; }
    __syncthreads();
}

DI void phase0(const Params& p, LAS unsigned char* lds) {
    const int tid = ltid(), wid = tid >> 6, lane = tid & 63, G = gridDim.x;
    SUB(0, for (int u = blockIdx.x; u < 192; u += G) p0_mod_unit(p, u, lds));
    LAS float* scr = (LAS float*)(lds + wid * 16384);
    const int gw = blockIdx.x * NWAVES + wid, NGW = G * NWAVES;
    constexpr int I_INE = 16 * 256, I_OUTE = 32 * 32, I_INO = 16 * 192, I_OUTO = 32 * 32, I_PW = 4 * 32;
    constexpr int NITEMS = I_INE + I_OUTE + I_INO + I_OUTO + I_PW;
    for (int it = (NGW - 1 - gw); it < NITEMS; it += NGW) {
        int r = it;
        if (r < I_INE) { p0_transpose_item(p.in[12], 1024, NIN_E, (bf16_t*)(p.ws + WS_WINE), scr, r, lane, true); continue; } r -= I_INE;
        if (r < I_OUTE) { p0_transpose_item(p.in[15], 2048, 1024, (bf16_t*)(p.ws + WS_WOUTE), scr, r, lane); continue; } r -= I_OUTE;
        if (r < I_INO) { p0_transpose_item(p.in[19], 1024, NIN_O, (bf16_t*)(p.ws + WS_WINO), scr, r, lane); continue; } r -= I_INO;
        if (r < I_OUTO) { p0_transpose_item(p.in[22], 2048, 1024, (bf16_t*)(p.ws + WS_WOUTO), scr, r, lane); continue; } r -= I_OUTO;
        { const int g = r >> 5; p0_transpose_item(p.in[20] + (size_t)g * 65536, 256, 256, (bf16_t*)(p.ws + WS_PWT) + (size_t)g * 65536, scr, r & 31, lane); }
    }
}

template <bool SRC_BF> DI void h_rows(const Params& p, int layer, const void* xpv  , const void* xsv  ) {
    const int tid = ltid(), wid = tid >> 6, lane = tid & 63, G = gridDim.x;
    const int gw = blockIdx.x * NWAVES + wid, NGW = G * NWAVES;
    const float* gn = layer ? p.in[16] : p.in[9];
    const float* MOD = (const float*)(p.ws + WS_MOD) + (size_t)layer * 36 * 3072;
    bf16_t* H = (bf16_t*)(p.ws + WS_H);
    for (int m0 = gw * 2; m0 < MT; m0 += NGW * 2) {
        f32x4 v[2][4]; float ss[2];
#pragma unroll
        for (int rr = 0; rr < 2; ++rr) { const int m = m0 + rr; ss[rr] = 0.f;
            if (SRC_BF) { const bf16_t* xrow = m < MP ? (const bf16_t*)xpv + (size_t)m * DM : (const bf16_t*)xsv + (size_t)(m - MP) * DM;
#pragma unroll
                for (int j = 0; j < 4; ++j) v[rr][j] = ld4bf(xrow + 4 * lane + 256 * j); }
            else { const float* xrow = m < MP ? (const float*)xpv + (size_t)m * DM : (const float*)xsv + (size_t)(m - MP) * DM;
#pragma unroll
                for (int j = 0; j < 4; ++j) v[rr][j] = *(const f32x4*)(xrow + 4 * lane + 256 * j); } }
#pragma unroll
        for (int rr = 0; rr < 2; ++rr) {
#pragma unroll
            for (int j = 0; j < 4; ++j) ss[rr] += (v[rr][j].x * v[rr][j].x + v[rr][j].y * v[rr][j].y) + (v[rr][j].z * v[rr][j].z + v[rr][j].w * v[rr][j].w); }
#pragma unroll
        for (int rr = 0; rr < 2; ++rr) { const int m = m0 + rr; const int bi = m < MP ? (m >> 12) : 4 + (m - MP); const float* md = MOD + (size_t)bi * 3072;
            const float rstd = rsqrtf(wave_sum(ss[rr]) * (1.f / DM) + EPS);
#pragma unroll
            for (int j = 0; j < 4; ++j) { const int col = 4 * lane + 256 * j;
                const f32x4 gv = *(const f32x4*)(gn + col), sh = *(const f32x4*)(md + col), sc = *(const f32x4*)(md + 1024 + col);
                const f32x4 y = v[rr][j] * rstd * gv * (sc + 1.0f) + sh;
                u32x2 o; o.x = pk2(y.x, y.y); o.y = pk2(y.z, y.w);
                *(u32x2*)(H + (size_t)m * DM + col) = o; } }
    }
}

struct EpiInE {
    static constexpr bool PERM = true;
    bf16_t* Z; float* kout; float* vout; float* convp;
    DI void operator()(const f32x4 (&acc)[2][2][4][2], const pg8::Unit& u, int wr, int wc, int fr, int fq) const {
        const int row0 = u.pm * 256 + wr * 64 + fr, colt = u.pn * 256 + wc * 32 + 8 * fq;
        if (u.pn < 16) {
            const int ch0 = u.pn * 64 + 16 * wc + 4 * fq;
#pragma unroll
            for (int ai = 0; ai < 2; ++ai)
#pragma unroll
                for (int m = 0; m < 4; ++m) { const int row = row0 + ai * 128 + m * 16; const int tl = row & 4095, b = row >> 12;
                    const f32x4 bg = acc[ai][0][m][0], cg = acc[ai][0][m][1], xv = acc[ai][1][m][0], ga = acc[ai][1][m][1];
                    const f32x4 uu = cg * xv; f32x4 gg;
#pragma unroll
                    for (int k = 0; k < 4; ++k) gg[k] = bg[k] * silu(ga[k]);
                    u32x2 wu, wg; wu.x = pk2(uu[0], uu[1]); wu.y = pk2(uu[2], uu[3]); wg.x = pk2(gg[0], gg[1]); wg.y = pk2(gg[2], gg[3]);
                    *(u32x2*)(Z + (size_t)row * ZLD + ch0) = wu; *(u32x2*)(Z + (size_t)row * ZLD + 1024 + ch0) = wg;
                    if (tl >= SEQ - 2) *(f32x4*)(convp + (size_t)(b * 2 + (tl - (SEQ - 2))) * 1024 + ch0) = uu;
                    asm volatile("" ::: "memory"); }
            return;
        }
        float* kv = nullptr; int kvc = 0;
        if (colt >= 5120 && colt < 6144) { kv = kout; kvc = colt - 5120; } else if (colt >= 6144 && colt < 7168) { kv = vout; kvc = colt - 6144; }
#pragma unroll
        for (int ai = 0; ai < 2; ++ai)
#pragma unroll
            for (int m = 0; m < 4; ++m) { const int row = row0 + ai * 128 + m * 16; const int tl = row & 4095, b = row >> 12;
#pragma unroll
                for (int bj = 0; bj < 2; ++bj) { const f32x4 v0 = acc[ai][bj][m][0], v1 = acc[ai][bj][m][1];
                    u32x4 w; w.x = pg8::cvt_pk_bf16(v0[0], v0[1]); w.y = pg8::cvt_pk_bf16(v0[2], v0[3]); w.z = pg8::cvt_pk_bf16(v1[0], v1[1]); w.w = pg8::cvt_pk_bf16(v1[2], v1[3]);
                    *(u32x4*)(Z + (size_t)row * ZLD + colt + bj * 128) = w;
                    if (kv && tl >= 2048) { float* o = kv + ((size_t)(b * 2048 + tl - 2048)) * 1024 + kvc + bj * 128; __builtin_nontemporal_store(v0, (f32x4*)o); __builtin_nontemporal_store(v1, (f32x4*)(o + 4)); } }
                asm volatile("" ::: "memory"); }
    }
};

DI void phase2(const Params& p, LAS unsigned char* lds) {
    bf16_t* H = (bf16_t*)(p.ws + WS_H); bf16_t* Z = (bf16_t*)(p.ws + WS_Z); const bf16_t* W = (const bf16_t*)(p.ws + WS_WINE);
    pg8::Gemm g{H, W, DM, DM, DM}; pg8::StaticOrder S; S.init(MP, NIN_E, gridDim.x, blockIdx.x, DM, DM);
    EpiInE E{Z, p.out + O_KP, p.out + O_VP, p.out + O_CONVP};
    pg8::gemm_phase<EpiInE, pg8::StaticOrder>(lds, g, S, E);
    float* ks = p.out + O_KS; float* vs = p.out + O_VS;
    small_gemm(lds, H + (size_t)MP * DM, DM, W, DM, DM, NIN_E, blockIdx.x, gridDim.x, [=](int row, int wrow, float v) {
        const int col = colmap_e(wrow);
        Z[(size_t)(MP + row) * ZLD + col] = (bf16_t)f2bf(v);
        if (col >= 5120 && col < 6144) ks[row * 1024 + col - 5120] = v; else if (col >= 6144 && col < 7168) vs[row * 1024 + col - 6144] = v; });
}


typedef short v4i16_t __attribute__((ext_vector_type(4)));
DI s16x4 tr_read(const LAS unsigned char* p) { return __builtin_bit_cast(s16x4, __builtin_amdgcn_ds_read_tr16_b64_v4i16((LAS v4i16_t*)p)); }
DI void unpack8(const u32x4 w, float (&f)[8]) { f[0] = bflo(w.x); f[1] = bfhi(w.x); f[2] = bflo(w.y); f[3] = bfhi(w.y); f[4] = bflo(w.z); f[5] = bfhi(w.z); f[6] = bflo(w.w); f[7] = bfhi(w.w); }
DI u32x4 pack8(const float (&f)[8]) { u32x4 w; w.x = pk2(f[0], f[1]); w.y = pk2(f[2], f[3]); w.z = pk2(f[4], f[5]); w.w = pk2(f[6], f[7]); return w; }
constexpr int VROW = 144;

DI void attn_item(const Params& p, LAS unsigned char* vb, int item, int lane) {
    const int r = item & 15, blk = (item >> 4) & 15, h = (item >> 8) & 15, b = item >> 12;
    const int c = lane & 15, quad = lane >> 4;
    const int t0 = blk * 256 + r;
    const bf16_t* Zb = (const bf16_t*)(p.ws + WS_Z) + (size_t)b * SEQ * ZLD;
    const bf16_t* qp = Zb + (size_t)(t0 + 16 * c) * ZLD + 4096 + h * 64 + quad * 8;
    const bf16x8 q0 = *(const bf16x8*)qp, q1 = *(const bf16x8*)(qp + 32);
    const float slope2 = exp2f(-0.5f * (float)(h + 1)) * LOG2E, sc2 = 0.125f * LOG2E;
    float m = -1e30f, l = 0.f;
    f32x4 o[4];
#pragma unroll
    for (int i = 0; i < 4; ++i) o[i] = (f32x4){0.f, 0.f, 0.f, 0.f};
    const int lrow = lane >> 3, lch = (lane & 7) * 8;
    const bf16_t* kbase = Zb + 5120 + h * 64 + lch;
    const bf16_t* vbase = Zb + 6144 + h * 64 + lch;
    LAS unsigned char* kb = vb + 32 * VROW;
    LAS unsigned char* kw = kb + lrow * VROW + lch * 2;
    LAS unsigned char* vw = vb + lrow * VROW + lch * 2;
    const LAS unsigned char* kr = kb + c * VROW + quad * 16;
    const LAS unsigned char* vr = vb + (4 * quad + (c >> 2)) * VROW + (c & 3) * 8;
    u32x4 kfA[4], kfB[4], kfC[4]; u32x4 vfA[4], vfB[4], vfC[4];
#define ATT_TILE(T, ld, ub) do { if ((T) < 12) { ld = 0; ub = -128 + 32 * (T); } else if ((T) < 18) { ld = 2; ub = -128 + 32 * ((T) - 12); } else { ld = 4; ub = -128 + 32 * ((T) - 18); } } while (0)
#define ATT_ISSUE(T, kf, vf) do { { int ld_, ub_; ATT_TILE(T, ld_, ub_); \
        _Pragma("unroll") for (int i_ = 0; i_ < 4; ++i_) { int r_ = t0 + ((ub_ + lrow + 8 * i_) << ld_); r_ = min(max(r_, 0), SEQ - 1); \
            kf[i_] = *(const u32x4*)(kbase + (size_t)r_ * ZLD); vf[i_] = *(const u32x4*)(vbase + (size_t)r_ * ZLD); } } } while (0)
#define ATT_BODY(T, kf, vf) do { { \
        int ld, ub; ATT_TILE(T, ld, ub); \
        asm volatile("" ::: "memory"); \
        _Pragma("unroll") for (int i_ = 0; i_ < 4; ++i_) { *(LAS u32x4*)(kw + i_ * 8 * VROW) = kf[i_]; *(LAS u32x4*)(vw + i_ * 8 * VROW) = vf[i_]; } \
        asm volatile("" ::: "memory"); \
        const bf16x8 k00 = *(const LAS bf16x8*)(kr), k01 = *(const LAS bf16x8*)(kr + 64), k10 = *(const LAS bf16x8*)(kr + 16 * VROW), k11 = *(const LAS bf16x8*)(kr + 16 * VROW + 64); \
        f32x4 s0 = (f32x4){0.f, 0.f, 0.f, 0.f}, s1 = s0; \
        s0 = __builtin_amdgcn_mfma_f32_16x16x32_bf16(k00, q0, s0, 0, 0, 0); s0 = __builtin_amdgcn_mfma_f32_16x16x32_bf16(k01, q1, s0, 0, 0, 0); \
        s1 = __builtin_amdgcn_mfma_f32_16x16x32_bf16(k10, q0, s1, 0, 0, 0); s1 = __builtin_amdgcn_mfma_f32_16x16x32_bf16(k11, q1, s1, 0, 0, 0); \
        float sv[8]; float mx = -INFINITY; \
        const int dmax = min(128 << ld, t0 + 16 * c), dbase = 16 * c - ((ub + 4 * quad) << ld); \
        _Pragma("unroll") for (int j = 0; j < 8; ++j) { \
            const int delta = dbase - ((((j >> 2) << 4) + (j & 3)) << ld); \
            const bool valid = (unsigned)delta <= (unsigned)dmax; \
            const float raw = (j < 4) ? s0[j & 3] : s1[j & 3]; \
            sv[j] = valid ? raw * sc2 - slope2 * (float)delta : -INFINITY; \
            mx = fmaxf(mx, sv[j]); } \
        mx = fmaxf(mx, __shfl_xor(mx, 16)); mx = fmaxf(mx, __shfl_xor(mx, 32)); \
        const float mn = fmaxf(m, mx), alpha = __builtin_amdgcn_exp2f(m - mn); m = mn; \
        float ps = 0.f; \
        _Pragma("unroll") for (int j = 0; j < 8; ++j) { sv[j] = __builtin_amdgcn_exp2f(sv[j] - mn); ps += sv[j]; } \
        l = l * alpha + ps; \
        _Pragma("unroll") for (int i = 0; i < 4; ++i) o[i] = o[i] * alpha; \
        u32x4 pw; pw.x = pk2(sv[0], sv[1]); pw.y = pk2(sv[2], sv[3]); pw.z = pk2(sv[4], sv[5]); pw.w = pk2(sv[6], sv[7]); \
        const bf16x8 pf = __builtin_bit_cast(bf16x8, pw); \
        _Pragma("unroll") for (int dt = 0; dt < 4; ++dt) { \
            const s16x4 lo = tr_read(vr + dt * 32), hi = tr_read(vr + 16 * VROW + dt * 32); \
            const bf16x8 vfr = __builtin_shufflevector(lo, hi, 0, 1, 2, 3, 4, 5, 6, 7); \
            o[dt] = __builtin_amdgcn_mfma_f32_16x16x32_bf16(vfr, pf, o[dt], 0, 0, 0); } \
        asm volatile("s_waitcnt lgkmcnt(0)" ::: "memory"); } } while (0)
    ATT_ISSUE(0, kfA, vfA); ATT_ISSUE(1, kfB, vfB); ATT_ISSUE(2, kfC, vfC);
#pragma unroll 1
    for (int T = 0; T < 24; T += 3) {
        ATT_BODY(T, kfA, vfA); ATT_ISSUE(T + 3, kfA, vfA);
        ATT_BODY(T + 1, kfB, vfB); ATT_ISSUE(T + 4, kfB, vfB);
        ATT_BODY(T + 2, kfC, vfC); ATT_ISSUE(T + 5, kfC, vfC);
    }
#undef ATT_BODY
#undef ATT_ISSUE
#undef ATT_TILE
    l += __shfl_xor(l, 16); l += __shfl_xor(l, 32);
    const float inv = 1.0f / l;
    const size_t row = (size_t)b * SEQ + t0 + 16 * c;
    const bf16_t* gbp = Zb + (size_t)(t0 + 16 * c) * ZLD + 7168 + h * 64 + 4 * quad;
    bf16_t* yp = (bf16_t*)(p.ws + WS_Y) + row * 2048 + 1024 + h * 64 + 4 * quad;
#pragma unroll
    for (int dt = 0; dt < 4; ++dt) {
        const u32x2 g = *(const u32x2*)(gbp + 16 * dt);
        u32x2 w; w.x = pk2(o[dt][0] * inv * silu(bflo(g.x)), o[dt][1] * inv * silu(bfhi(g.x))); w.y = pk2(o[dt][2] * inv * silu(bflo(g.y)), o[dt][3] * inv * silu(bfhi(g.y)));
        *(u32x2*)(yp + 16 * dt) = w;
    }
}

constexpr int AST_BYTES = 70656;
DI int ast_addr(int tl) { return tl * 68 + (tl >> 4) * 4; }
DI void attn_block(const Params& p, LAS unsigned char* lds, int bh, int blk, int wid, int lane) {
    const int b = bh >> 4, h = bh & 15, T0 = blk * 256;
    const int c = lane & 15, quad = lane >> 4;
    LAS float* st = (LAS float*)lds;
    LAS unsigned char* vb = lds + AST_BYTES + wid * 9216;
    const bf16_t* Zb = (const bf16_t*)(p.ws + WS_Z) + (size_t)b * SEQ * ZLD;
    const float slope2 = exp2f(-0.5f * (float)(h + 1)) * LOG2E, sc2 = 0.125f * LOG2E;
    const int lrow = lane >> 3, lch = (lane & 7) * 8;
    const bf16_t* kbase = Zb + 5120 + h * 64 + lch;
    const bf16_t* vbase = Zb + 6144 + h * 64 + lch;
    LAS unsigned char* kb = vb + 32 * VROW;
    LAS unsigned char* kw = kb + lrow * VROW + lch * 2;
    LAS unsigned char* vw = vb + lrow * VROW + lch * 2;
    const LAS unsigned char* kr = kb + c * VROW + quad * 16;
    const LAS unsigned char* vr = vb + (4 * quad + (c >> 2)) * VROW + (c & 3) * 8;
    u32x4 kfA[4], kfB[4], kfC[4], vfA[4], vfB[4], vfC[4];
    bf16x8 qa0, qa1, qb0, qb1, qna0, qna1, qnb0, qnb1; u32x2 gate[4];
    float mA = -1e30f, lA = 0.f, mB = -1e30f, lB = 0.f; f32x4 oA[4], oB[4];
#pragma unroll
    for (int i = 0; i < 4; ++i) { oA[i] = (f32x4){0.f, 0.f, 0.f, 0.f}; oB[i] = oA[i]; gate[i] = (u32x2){0u, 0u}; }
    qb0 = (bf16x8){0, 0, 0, 0, 0, 0, 0, 0}; qb1 = qb0; qnb0 = qb0; qnb1 = qb0;
#define AB_GEOM(T) const int T_ = min((int)(T), 19); const int pass = T_ < 5 ? 0 : (T_ < 10 ? 1 : 2), ti = T_ % 5, ld = 2 * pass; \
        const int qoff = pass == 0 ? 32 * wid : (pass == 1 ? (wid & 3) + 128 * (wid >> 2) : 2 * wid + (T_ >= 15 ? 1 : 0)), tp = 4 - ti, ub = -128 + 32 * tp
#define AB_QLOAD(T) do { AB_GEOM(T); (void)ub; (void)ti; (void)tp; const bf16_t* qp_ = Zb + (size_t)(T0 + qoff + (c << ld)) * ZLD + 4096 + h * 64 + quad * 8; qna0 = *(const bf16x8*)qp_; qna1 = *(const bf16x8*)(qp_ + 32); \
        if (pass < 2) { const bf16_t* qq_ = qp_ + (size_t)(16 << ld) * ZLD; qnb0 = *(const bf16x8*)qq_; qnb1 = *(const bf16x8*)(qq_ + 32); } } while (0)
#define AB_ISSUE(T, kf, vf) do { AB_GEOM(T); (void)tp; \
        _Pragma("unroll") for (int i_ = 0; i_ < 4; ++i_) { int r_ = T0 + qoff + ((ub + lrow + 8 * i_) << ld); r_ = min(max(r_, 0), SEQ - 1); \
            kf[i_] = *(const u32x4*)(kbase + (size_t)r_ * ZLD); vf[i_] = *(const u32x4*)(vbase + (size_t)r_ * ZLD); } } while (0)
#define AB_STLOAD(o, m, l, tlx) do { const LAS float* sp_ = st + ast_addr(tlx); _Pragma("unroll") for (int i_ = 0; i_ < 4; ++i_) o[i_] = *(const LAS f32x4*)(sp_ + 16 * i_ + 4 * quad); \
        m = sp_[64]; const float lt_ = sp_[65]; l = quad == 0 ? lt_ : 0.f; } while (0)
#define AB_STSTORE(o, m, l, tlx) do { float lt_ = l; lt_ += __shfl_xor(lt_, 16); lt_ += __shfl_xor(lt_, 32); LAS float* sp_ = st + ast_addr(tlx); \
        _Pragma("unroll") for (int i_ = 0; i_ < 4; ++i_) *(LAS f32x4*)(sp_ + 16 * i_ + 4 * quad) = o[i_]; if (quad == 0) { sp_[64] = m; sp_[65] = lt_; } } while (0)
#define AB_GROUP(q0, q1, o, m, l, dbase_, tlx) do { \
        f32x4 s0 = (f32x4){0.f, 0.f, 0.f, 0.f}, s1 = s0; \
        s0 = __builtin_amdgcn_mfma_f32_16x16x32_bf16(k00, q0, s0, 0, 0, 0); s0 = __builtin_amdgcn_mfma_f32_16x16x32_bf16(k01, q1, s0, 0, 0, 0); \
        s1 = __builtin_amdgcn_mfma_f32_16x16x32_bf16(k10, q0, s1, 0, 0, 0); s1 = __builtin_amdgcn_mfma_f32_16x16x32_bf16(k11, q1, s1, 0, 0, 0); \
        float sv[8]; float mx; const float b0 = -sl * (float)(dbase_); \
        if (need_mask) { \
            const int dmax = min(128, (T0 + (tlx)) >> ld); mx = -INFINITY; \
            _Pragma("unroll") for (int j = 0; j < 8; ++j) { const int jo = ((j >> 2) << 4) + (j & 3); \
                const bool valid = (unsigned)((dbase_) - jo) <= (unsigned)dmax; const float raw = (j < 4) ? s0[j & 3] : s1[j & 3]; \
                sv[j] = valid ? raw * sc2 + (b0 + sl * (float)jo) : -INFINITY; mx = fmaxf(mx, sv[j]); } \
        } else { \
            _Pragma("unroll") for (int j = 0; j < 8; ++j) { const int jo = ((j >> 2) << 4) + (j & 3); const float raw = (j < 4) ? s0[j & 3] : s1[j & 3]; sv[j] = raw * sc2 + (b0 + sl * (float)jo); } \
            mx = fmaxf(fmaxf(fmaxf(sv[0], sv[1]), fmaxf(sv[2], sv[3])), fmaxf(fmaxf(sv[4], sv[5]), fmaxf(sv[6], sv[7]))); \
        } \
        if (__builtin_amdgcn_ballot_w64(mx > m) != 0ull) {     \
            mx = fmaxf(mx, __shfl_xor(mx, 16)); mx = fmaxf(mx, __shfl_xor(mx, 32)); \
            const float mn = fmaxf(m, mx), alpha = __builtin_amdgcn_exp2f(m - mn); m = mn; l = l * alpha; \
            _Pragma("unroll") for (int i_ = 0; i_ < 4; ++i_) o[i_] = o[i_] * alpha; } \
        float ps = 0.f; \
        _Pragma("unroll") for (int j = 0; j < 8; ++j) { sv[j] = __builtin_amdgcn_exp2f(sv[j] - m); ps += sv[j]; } \
        l += ps; \
        u32x4 pw; pw.x = pk2(sv[0], sv[1]); pw.y = pk2(sv[2], sv[3]); pw.z = pk2(sv[4], sv[5]); pw.w = pk2(sv[6], sv[7]); \
        const bf16x8 pf = __builtin_bit_cast(bf16x8, pw); \
        _Pragma("unroll") for (int dt = 0; dt < 4; ++dt) o[dt] = __builtin_amdgcn_mfma_f32_16x16x32_bf16(vfr[dt], pf, o[dt], 0, 0, 0); } while (0)
#define AB_STEP(T, kf, vf) do { if ((T) < 20) { AB_GEOM(T); const int tl = qoff + (c << ld), tlb = tl + (16 << ld); \
        if (ti == 0) {     \
            if (T_ == 0 || T_ == 5 || T_ == 10) __syncthreads(); \
            qa0 = qna0; qa1 = qna1; qb0 = qnb0; qb1 = qnb1; \
            if (pass == 0) { mA = -1e30f; lA = 0.f; mB = -1e30f; lB = 0.f; _Pragma("unroll") for (int i_ = 0; i_ < 4; ++i_) { oA[i_] = (f32x4){0.f, 0.f, 0.f, 0.f}; oB[i_] = oA[i_]; } } \
            else { AB_STLOAD(oA, mA, lA, tl); if (pass == 1) AB_STLOAD(oB, mB, lB, tlb); } \
            if (pass == 2) { const bf16_t* gp_ = Zb + (size_t)(T0 + tl) * ZLD + 7168 + h * 64 + 4 * quad; _Pragma("unroll") for (int i_ = 0; i_ < 4; ++i_) gate[i_] = *(const u32x2*)(gp_ + 16 * i_); } \
        } \
        if (ti == 2) AB_QLOAD((T) + 3);     \
        asm volatile("" ::: "memory"); \
        _Pragma("unroll") for (int i_ = 0; i_ < 4; ++i_) { *(LAS u32x4*)(kw + i_ * 8 * VROW) = kf[i_]; *(LAS u32x4*)(vw + i_ * 8 * VROW) = vf[i_]; } \
        asm volatile("" ::: "memory"); \
        const bf16x8 k00 = *(const LAS bf16x8*)(kr), k01 = *(const LAS bf16x8*)(kr + 64), k10 = *(const LAS bf16x8*)(kr + 16 * VROW), k11 = *(const LAS bf16x8*)(kr + 16 * VROW + 64); \
        bf16x8 vfr[4]; \
        _Pragma("unroll") for (int dt = 0; dt < 4; ++dt) { const s16x4 lo = tr_read(vr + dt * 32), hi = tr_read(vr + 16 * VROW + dt * 32); vfr[dt] = __builtin_shufflevector(lo, hi, 0, 1, 2, 3, 4, 5, 6, 7); } \
        const int dbase = c - ub - 4 * quad; const float sl = slope2 * (float)(1 << ld); \
        const bool need_mask = (tp == 0 || tp == 4 || (T0 + qoff + (ub << ld)) < 0); \
        AB_GROUP(qa0, qa1, oA, mA, lA, dbase, tl); \
        if (pass < 2) AB_GROUP(qb0, qb1, oB, mB, lB, dbase + 16, tlb); \
        asm volatile("s_waitcnt lgkmcnt(0)" ::: "memory"); \
        if (ti == 4) {     \
            if (pass < 2) { AB_STSTORE(oA, mA, lA, tl); AB_STSTORE(oB, mB, lB, tlb); } \
            else { float lt_ = lA; lt_ += __shfl_xor(lt_, 16); lt_ += __shfl_xor(lt_, 32); \
                const float inv_ = 1.0f / lt_; bf16_t* yp_ = (bf16_t*)(p.ws + WS_Y) + ((size_t)b * SEQ + T0 + tl) * 2048 + 1024 + h * 64 + 4 * quad; \
                _Pragma("unroll") for (int i_ = 0; i_ < 4; ++i_) { const u32x2 g = gate[i_]; u32x2 w; \
                    w.x = pk2(oA[i_][0] * inv_ * silu(bflo(g.x)), oA[i_][1] * inv_ * silu(bfhi(g.x))); w.y = pk2(oA[i_][2] * inv_ * silu(bflo(g.y)), oA[i_][3] * inv_ * silu(bfhi(g.y))); \
                    *(u32x2*)(yp_ + 16 * i_) = w; } } \
        } } } while (0)
    AB_QLOAD(0);
    AB_ISSUE(0, kfA, vfA); AB_ISSUE(1, kfB, vfB); AB_ISSUE(2, kfC, vfC);
#pragma unroll 1
    for (int T = 0; T < 21; T += 3) {
        AB_STEP(T, kfA, vfA); AB_ISSUE(T + 3, kfA, vfA);
        AB_STEP(T + 1, kfB, vfB); AB_ISSUE(T + 4, kfB, vfB);
        AB_STEP(T + 2, kfC, vfC); AB_ISSUE(T + 5, kfC, vfC);
    }
#undef AB_STEP
#undef AB_GROUP
#undef AB_STSTORE
#undef AB_STLOAD
#undef AB_ISSUE
#undef AB_QLOAD
#undef AB_GEOM
}

DI void conv_item(const Params& p, int item, int lane) {
    const int chunk = item >> 1, ch = (item & 1) * 512 + lane * 8;
    const int row0 = chunk * 8, tl0 = row0 & (SEQ - 1);
    const bf16_t* Z = (const bf16_t*)(p.ws + WS_Z); bf16_t* Y = (bf16_t*)(p.ws + WS_Y);
    float cw0[8], cw1[8], cw2[8], cb[8], up1[8], up2[8];
#pragma unroll
    for (int i = 0; i < 8; ++i) { cw0[i] = p.in[13][ch + i]; cw1[i] = p.in[13][1024 + ch + i]; cw2[i] = p.in[13][2048 + ch + i]; cb[i] = p.in[14][ch + i]; up1[i] = 0.f; up2[i] = 0.f; }
    u32x4 ur[10], gr[8];
#pragma unroll
    for (int t = 0; t < 10; ++t) { ur[t] = (u32x4){0u, 0u, 0u, 0u}; if (t >= 2 || tl0 > 0) ur[t] = __builtin_nontemporal_load((const u32x4*)(Z + (size_t)(row0 - 2 + t) * ZLD + ch)); }
#pragma unroll
    for (int t = 0; t < 8; ++t) gr[t] = __builtin_nontemporal_load((const u32x4*)(Z + (size_t)(row0 + t) * ZLD + 1024 + ch));
    unpack8(ur[0], up2); unpack8(ur[1], up1);
#pragma unroll
    for (int t = 0; t < 8; ++t) {
        float u[8], g[8], y[8]; unpack8(ur[t + 2], u); unpack8(gr[t], g);
#pragma unroll
        for (int i = 0; i < 8; ++i) { const float cv = cb[i] + cw0[i] * up2[i] + cw1[i] * up1[i] + cw2[i] * u[i]; y[i] = g[i] * cv; up2[i] = up1[i]; up1[i] = u[i]; }
        *(u32x4*)(Y + (size_t)(row0 + t) * 2048 + ch) = pack8(y);
    }
}

DI void decode_pair(const Params& p, LAS float* L  , int pairidx, int wid, int lane) {
    const int item = pairidx * 2 + (wid >> 2), kq = wid & 3;
    const int b = item >> 4, h = item & 15;
    const bf16_t* zrow = (const bf16_t*)(p.ws + WS_Z) + (size_t)(MP + b) * ZLD;
    LAS float* wl = L + wid * 272; LAS float* qs = wl; LAS float* pb = wl + 64; LAS float* ob = wl + 192;
    qs[lane] = bf2f(zrow[4096 + h * 64 + lane]) * 0.125f;
    asm volatile("s_waitcnt lgkmcnt(0)" ::: "memory");
    const float slope = exp2f(-0.5f * (float)(h + 1));
    const float* ck = p.in[5]; const float* cv = p.in[6];
    const float* knew = p.out + O_KS + b * 1024 + h * 64; const float* vnew = p.out + O_VS + b * 1024 + h * 64;
    float sc[2]; float mx = -INFINITY;
#pragma unroll
    for (int i = 0; i < 2; ++i) {
        const int e = kq + 4 * (lane + 64 * i);
        sc[i] = -INFINITY;
        if (e < 387) {
            const int pi = e / 129, j = e - pi * 129, d = 1 << (2 * pi), idx = 2048 - j * d;
            const float* kr = (idx == 2048) ? knew : ck + ((size_t)(b * 2048 + idx) * 16 + h) * 64;
            float dot = 0.f;
#pragma unroll
            for (int dd = 0; dd < 64; dd += 4) { const f32x4 kv = __builtin_nontemporal_load((const f32x4*)(kr + dd)); const f32x4 qv = *(const LAS f32x4*)(qs + dd); dot += kv.x * qv.x + kv.y * qv.y + kv.z * qv.z + kv.w * qv.w; }
            sc[i] = dot - slope * (float)(j * d);
        }
        mx = fmaxf(mx, sc[i]);
    }
    mx = wave_max(mx);
    float ls = 0.f;
#pragma unroll
    for (int i = 0; i < 2; ++i) { const float pe = __expf(sc[i] - mx); ls += pe; pb[lane + 64 * i] = pe; }
    ls = wave_sum(ls);
    asm volatile("s_waitcnt lgkmcnt(0)" ::: "memory");
    const int g = lane >> 4, dq = (lane & 15) * 4;
    f32x4 acc = (f32x4){0.f, 0.f, 0.f, 0.f};
#pragma unroll 5
    for (int n = g; n < 97; n += 4) {
        const int e = kq + 4 * n;
        if (e < 387) {
            const int pi = e / 129, j = e - pi * 129, d = 1 << (2 * pi), idx = 2048 - j * d;
            const float* vr = (idx == 2048) ? vnew : cv + ((size_t)(b * 2048 + idx) * 16 + h) * 64;
            acc += __builtin_nontemporal_load((const f32x4*)(vr + dq)) * pb[n];
        }
    }
#pragma unroll
    for (int k = 0; k < 4; ++k) { float t = acc[k]; t += __shfl_xor(t, 16); t += __shfl_xor(t, 32); acc[k] = t; }
    if (lane < 16) *(LAS f32x4*)(ob + dq) = acc;
    if (lane == 0) { wl[256] = mx; wl[257] = ls; }
    __syncthreads();
    if (kq == 0 && lane < 16) {
        const LAS float* w0 = L + wid * 272;
        float M = fmaxf(fmaxf(w0[256], w0[272 + 256]), fmaxf(w0[544 + 256], w0[816 + 256]));
        float lt = 0.f; f32x4 ot = (f32x4){0.f, 0.f, 0.f, 0.f};
#pragma unroll
        for (int q = 0; q < 4; ++q) { const float f = __expf(w0[q * 272 + 256] - M); lt += f * w0[q * 272 + 257]; ot += *(const LAS f32x4*)(w0 + q * 272 + 192 + dq) * f; }
        const float inv = 1.0f / lt;
        const u32x2 gw = *(const u32x2*)(zrow + 7168 + h * 64 + dq);
        u32x2 w; w.x = pk2(ot[0] * inv * silu(bflo(gw.x)), ot[1] * inv * silu(bfhi(gw.x))); w.y = pk2(ot[2] * inv * silu(bflo(gw.y)), ot[3] * inv * silu(bfhi(gw.y)));
        *(u32x2*)((bf16_t*)(p.ws + WS_Y) + (size_t)(MP + b) * 2048 + 1024 + h * 64 + dq) = w;
    }
    __syncthreads();
}

DI void phase3(const Params& p, LAS unsigned char* lds) {
    const int tid = ltid(), wid = tid >> 6, lane = tid & 63, G = gridDim.x;
    const int gw = blockIdx.x * NWAVES + wid, NGW = G * NWAVES;
    for (int it = blockIdx.x; it < 256; it += G) decode_pair(p, (LAS float*)lds, it, wid, lane);
    LAS unsigned char* wl = lds + wid * 10240;
    if (G == 256) {
        const int x = blockIdx.x & 7, lw = (blockIdx.x >> 3) * NWAVES + wid;
        (void)lw; const int lb = blockIdx.x >> 3;
        for (int k2 = 0; k2 < 4; ++k2) attn_block(p, lds, x * 8 + 2 * k2 + (lb >> 4), lb & 15, wid, lane);
        __syncthreads();
    } else
        for (int it = gw; it < 16384; it += NGW) attn_item(p, wl, it, lane);
    for (int it = gw; it < 4096; it += NGW) conv_item(p, it, lane);
    for (int it = blockIdx.x * NTHREADS + tid; it < NS * 128; it += G * NTHREADS) {
        const int b = it >> 7, ch = (it & 127) * 8;
        const bf16_t* zr = (const bf16_t*)(p.ws + WS_Z) + (size_t)(MP + b) * ZLD + ch;
        float bg[8], cg[8], xv[8], ga[8], y[8];
        unpack8(*(const u32x4*)zr, bg); unpack8(*(const u32x4*)(zr + 1024), cg); unpack8(*(const u32x4*)(zr + 2048), xv); unpack8(*(const u32x4*)(zr + 3072), ga);
        const float* s0 = p.in[4] + (size_t)(b * 2) * 1024 + ch; const float* s1 = s0 + 1024;
        float* o0 = p.out + O_CONVS + (size_t)(b * 2) * 1024 + ch; float* o1 = o0 + 1024;
#pragma unroll
        for (int i = 0; i < 8; ++i) { const float u = cg[i] * xv[i]; const float cv = p.in[14][ch + i] + p.in[13][ch + i] * s0[i] + p.in[13][1024 + ch + i] * s1[i] + p.in[13][2048 + ch + i] * u;
            y[i] = bg[i] * cv * silu(ga[i]); o0[i] = s1[i]; o1[i] = u; }
        *(u32x4*)((bf16_t*)(p.ws + WS_Y) + (size_t)(MP + b) * 2048 + ch) = pack8(y);
    }
}

template <bool BASE_BF> struct EpiRes {
    static constexpr bool PERM = false;
    const void* base; bf16_t* out; const float* mod;
    DI void operator()(const f32x4 (&acc)[2][2][4][2], const pg8::Unit& u, int wr, int wc, int fr, int fq) const {
        const int row0 = u.pm * 256 + wr * 64 + fr, col0 = u.pn * 256 + wc * 32 + 4 * fq;
#pragma unroll
        for (int ai = 0; ai < 2; ++ai)
#pragma unroll
            for (int m = 0; m < 4; ++m) { const int row = row0 + ai * 128 + m * 16; const float* gate = mod + (size_t)(row >> 12) * 3072 + 2048;
#pragma unroll
                for (int bj = 0; bj < 2; ++bj)
#pragma unroll
                    for (int n = 0; n < 2; ++n) { const int col = col0 + bj * 128 + n * 16; const size_t off = (size_t)row * DM + col;
                        const f32x4 x = BASE_BF ? ld4bf((const bf16_t*)base + off) : __builtin_nontemporal_load((const f32x4*)((const float*)base + off));
                        const f32x4 gt = *(const f32x4*)(gate + col), y = x + gt * acc[ai][bj][m][n];
                        u32x2 w; w.x = pk2(y.x, y.y); w.y = pk2(y.z, y.w); *(u32x2*)(out + off) = w; }
                asm volatile("" ::: "memory"); }
    }
};
DI void phase_out(const Params& p, LAS unsigned char* lds, int layer) {
    const bf16_t* Y = (const bf16_t*)(p.ws + WS_Y); const bf16_t* W = (const bf16_t*)(p.ws + (layer ? WS_WOUTO : WS_WOUTE));
    bf16_t* XB = (bf16_t*)(p.ws + WS_X1); const float* mod = (const float*)(p.ws + WS_MOD) + (size_t)layer * 36 * 3072;
    pg8::Gemm g{Y, W, 2048, 2048, 2048}; pg8::StaticOrder S; S.init(MP, DM, gridDim.x, blockIdx.x, 2048, 2048);
    if (layer) { EpiRes<true> E{XB, XB, mod}; pg8::gemm_phase<EpiRes<true>, pg8::StaticOrder>(lds, g, S, E); }
    else { EpiRes<false> E{p.in[0], XB, mod}; pg8::gemm_phase<EpiRes<false>, pg8::StaticOrder>(lds, g, S, E); }
    bf16_t* os = XB + (size_t)MP * DM; const float* xs0 = p.in[1];
    small_gemm(lds, Y + (size_t)MP * 2048, 2048, W, 2048, 2048, DM, blockIdx.x, gridDim.x, [=](int row, int col, float v) {
        const float bs = layer ? bf2f(os[row * DM + col]) : xs0[row * DM + col];
        os[row * DM + col] = (bf16_t)f2bf(bs + mod[(size_t)(4 + row) * 3072 + 2048 + col] * v); });
}


struct EpiFinal {
    static constexpr bool PERM = false;
    const bf16_t* xb; const float* mod; const float* gn; float* yout; float* slots; unsigned* cnt; LAS float* X;
    DI void operator()(f32x4 (&acc)[2][2][4][2], const pg8::Unit& u, int wr, int wc, int fr, int fq) const {
        const int tid = ltid(), wid = tid >> 6, lane = tid & 63;
        const int row0 = u.pm * 256 + wr * 64 + fr, col0 = u.pn * 256 + wc * 32 + 4 * fq;
#pragma unroll
        for (int ai = 0; ai < 2; ++ai)
#pragma unroll
            for (int m = 0; m < 4; ++m) { const int row = row0 + ai * 128 + m * 16; const float* gate = mod + (size_t)(row >> 12) * 3072 + 2048; float ss = 0.f;
#pragma unroll
                for (int bj = 0; bj < 2; ++bj)
#pragma unroll
                    for (int n = 0; n < 2; ++n) { const int col = col0 + bj * 128 + n * 16;
                        const f32x4 x = ld4bf(xb + (size_t)row * DM + col), gt = *(const f32x4*)(gate + col), y = x + gt * acc[ai][bj][m][n];
                        acc[ai][bj][m][n] = y; ss += (y.x * y.x + y.y * y.y) + (y.z * y.z + y.w * y.w); }
                ss += __shfl_xor(ss, 16); ss += __shfl_xor(ss, 32);
                if (fq == 0) X[(ai * 128 + wr * 64 + m * 16 + fr) * 4 + wc] = ss;
                asm volatile("" ::: "memory"); }
        asm volatile("s_waitcnt lgkmcnt(0)" ::: "memory"); __builtin_amdgcn_s_barrier(); asm volatile("" ::: "memory");
        if (tid < 256) { const f32x4 pp = *(const LAS f32x4*)(X + tid * 4);
            __hip_atomic_store(slots + ((size_t)u.pm * 256 + tid) * 4 + u.pn, (pp.x + pp.y) + (pp.z + pp.w), __ATOMIC_RELAXED, __HIP_MEMORY_SCOPE_AGENT); }
        asm volatile("s_waitcnt vmcnt(0)" ::: "memory");
        if (tid < 256 && lane == 0) __hip_atomic_fetch_add(cnt + u.pm, 1u, __ATOMIC_RELAXED, __HIP_MEMORY_SCOPE_AGENT);
        if (wid == 0) { unsigned spins = 0;
            while ((unsigned)__builtin_amdgcn_readfirstlane(__hip_atomic_load(cnt + u.pm, __ATOMIC_RELAXED, __HIP_MEMORY_SCOPE_AGENT)) < 16u && ++spins < (1u << 22)) __builtin_amdgcn_s_sleep(2);
            __builtin_amdgcn_fence(__ATOMIC_ACQUIRE, "agent"); }
        asm volatile("s_waitcnt vmcnt(0) lgkmcnt(0)" ::: "memory"); __builtin_amdgcn_s_barrier(); asm volatile("" ::: "memory");
        if (tid < 256) { const float* sl = slots + ((size_t)u.pm * 256 + tid) * 4; float tot = 0.f;
#pragma unroll
            for (int t = 0; t < 4; ++t) tot += __hip_atomic_load(sl + t, __ATOMIC_RELAXED, __HIP_MEMORY_SCOPE_AGENT);
            X[1024 + tid] = rsqrtf(tot * (1.0f / DM) + EPS); }
        asm volatile("s_waitcnt vmcnt(0) lgkmcnt(0)" ::: "memory"); __builtin_amdgcn_s_barrier(); asm volatile("" ::: "memory");
#pragma unroll
        for (int ai = 0; ai < 2; ++ai)
#pragma unroll
            for (int m = 0; m < 4; ++m) { const int rl = ai * 128 + wr * 64 + m * 16 + fr; const float rs = X[1024 + rl]; float* orow = yout + ((size_t)u.pm * 256 + rl) * DM;
#pragma unroll
                for (int bj = 0; bj < 2; ++bj)
#pragma unroll
                    for (int n = 0; n < 2; ++n) { const int col = col0 + bj * 128 + n * 16;
                        __builtin_nontemporal_store(acc[ai][bj][m][n] * rs * *(const f32x4*)(gn + col), (f32x4*)(orow + col)); }
                asm volatile("" ::: "memory"); }
        asm volatile("s_waitcnt lgkmcnt(0)" ::: "memory"); __builtin_amdgcn_s_barrier(); asm volatile("" ::: "memory");
    }
};
DI void phase_out_final(const Params& p, LAS unsigned char* lds) {
    const int tid = ltid(), wid = tid >> 6;
    const bf16_t* Y = (const bf16_t*)(p.ws + WS_Y); const bf16_t* W = (const bf16_t*)(p.ws + WS_WOUTO);
    const bf16_t* XB = (const bf16_t*)(p.ws + WS_X1); const float* mod = (const float*)(p.ws + WS_MOD) + (size_t)36 * 3072;
    float* slots = (float*)(p.ws + WS_XSLOT); unsigned* cnt = (unsigned*)(p.ws + WS_BAR) + XCNT_WORD;
    pg8::Gemm g{Y, W, 2048, 2048, 2048}; pg8::StaticOrder S; S.init(MP, DM, gridDim.x, blockIdx.x, 2048, 2048);
    EpiFinal E{XB, mod, p.in[23], p.out + O_YP, slots, cnt, (LAS float*)(lds + 131072 + 1024)};
    pg8::gemm_phase<EpiFinal, pg8::StaticOrder>(lds, g, S, E);
    LAS float* T = (LAS float*)(lds + 40960); LAS float* Rs = T + 32 * 33;
    const bf16_t* xs = XB + (size_t)MP * DM;
    small_gemm(lds, Y + (size_t)MP * 2048, 2048, W, 2048, 2048, DM, blockIdx.x, gridDim.x, [=](int row, int col, float v) {
        T[row * 33 + (col & 31)] = bf2f(xs[row * DM + col]) + mod[(size_t)(4 + row) * 3072 + 2048 + col] * v; });
    if (blockIdx.x < 32) {
        float* ss_slots = slots + (size_t)MP * 4; const int n0 = blockIdx.x * 32;
        if (tid < 32) { float ss = 0.f;
#pragma unroll 8
            for (int c = 0; c < 32; ++c) { const float t = T[tid * 33 + c]; ss += t * t; }
            __hip_atomic_store(ss_slots + tid * 32 + blockIdx.x, ss, __ATOMIC_RELAXED, __HIP_MEMORY_SCOPE_AGENT); }
        asm volatile("s_waitcnt vmcnt(0)" ::: "memory");
        if (tid == 0) __hip_atomic_fetch_add(cnt + 64, 1u, __ATOMIC_RELAXED, __HIP_MEMORY_SCOPE_AGENT);
        if (wid == 0) { unsigned spins = 0;
            while ((unsigned)__builtin_amdgcn_readfirstlane(__hip_atomic_load(cnt + 64, __ATOMIC_RELAXED, __HIP_MEMORY_SCOPE_AGENT)) < 32u && ++spins < (1u << 22)) __builtin_amdgcn_s_sleep(2);
            __builtin_amdgcn_fence(__ATOMIC_ACQUIRE, "agent"); }
        __syncthreads();
        if (tid < 32) { float tot = 0.f;
            for (int t = 0; t < 32; ++t) tot += __hip_atomic_load(ss_slots + tid * 32 + t, __ATOMIC_RELAXED, __HIP_MEMORY_SCOPE_AGENT);
            Rs[tid] = rsqrtf(tot * (1.0f / DM) + EPS); }
        __syncthreads();
        for (int e = tid; e < 1024; e += NTHREADS) { const int r = e >> 5, c = e & 31; p.out[O_YS + (size_t)r * DM + n0 + c] = T[r * 33 + c] * Rs[r] * p.in[23][n0 + c]; }
    }
}


struct EpiMid {
    static constexpr bool PERM = false;
    const float* xin; const float* mod0; const float* mod1; const float* gno; bf16_t* xb; bf16_t* H; float* slots; unsigned* cnt; LAS float* X;
    DI void operator()(f32x4 (&acc)[2][2][4][2], const pg8::Unit& u, int wr, int wc, int fr, int fq) const {
        const int tid = ltid(), wid = tid >> 6, lane = tid & 63;
        const int row0 = u.pm * 256 + wr * 64 + fr, col0 = u.pn * 256 + wc * 32 + 4 * fq;
#pragma unroll
        for (int ai = 0; ai < 2; ++ai)
#pragma unroll
            for (int m = 0; m < 4; ++m) { const int row = row0 + ai * 128 + m * 16; const float* gate = mod0 + (size_t)(row >> 12) * 3072 + 2048; float ss = 0.f;
#pragma unroll
                for (int bj = 0; bj < 2; ++bj)
#pragma unroll
                    for (int n = 0; n < 2; ++n) { const int col = col0 + bj * 128 + n * 16; const size_t off = (size_t)row * DM + col;
                        const f32x4 x = __builtin_nontemporal_load((const f32x4*)(xin + off)), gt = *(const f32x4*)(gate + col), y = x + gt * acc[ai][bj][m][n];
                        acc[ai][bj][m][n] = y; ss += (y.x * y.x + y.y * y.y) + (y.z * y.z + y.w * y.w);
                        u32x2 w; w.x = pk2(y.x, y.y); w.y = pk2(y.z, y.w); *(u32x2*)(xb + off) = w; }
                ss += __shfl_xor(ss, 16); ss += __shfl_xor(ss, 32);
                if (fq == 0) X[(ai * 128 + wr * 64 + m * 16 + fr) * 4 + wc] = ss;
                asm volatile("" ::: "memory"); }
        asm volatile("s_waitcnt lgkmcnt(0)" ::: "memory"); __builtin_amdgcn_s_barrier(); asm volatile("" ::: "memory");
        if (tid < 256) { const f32x4 pp = *(const LAS f32x4*)(X + tid * 4);
            __hip_atomic_store(slots + ((size_t)u.pm * 256 + tid) * 4 + u.pn, (pp.x + pp.y) + (pp.z + pp.w), __ATOMIC_RELAXED, __HIP_MEMORY_SCOPE_AGENT); }
        asm volatile("s_waitcnt vmcnt(0)" ::: "memory");
        if (tid < 256 && lane == 0) __hip_atomic_fetch_add(cnt + u.pm, 1u, __ATOMIC_RELAXED, __HIP_MEMORY_SCOPE_AGENT);
        if (wid == 0) { unsigned spins = 0;
            while ((unsigned)__builtin_amdgcn_readfirstlane(__hip_atomic_load(cnt + u.pm, __ATOMIC_RELAXED, __HIP_MEMORY_SCOPE_AGENT)) < 16u && ++spins < (1u << 22)) __builtin_amdgcn_s_sleep(2);
            __builtin_amdgcn_fence(__ATOMIC_ACQUIRE, "agent"); }
        asm volatile("s_waitcnt vmcnt(0) lgkmcnt(0)" ::: "memory"); __builtin_amdgcn_s_barrier(); asm volatile("" ::: "memory");
        if (tid < 256) { const float* sl = slots + ((size_t)u.pm * 256 + tid) * 4; float tot = 0.f;
#pragma unroll
            for (int t = 0; t < 4; ++t) tot += __hip_atomic_load(sl + t, __ATOMIC_RELAXED, __HIP_MEMORY_SCOPE_AGENT);
            X[1024 + tid] = rsqrtf(tot * (1.0f / DM) + EPS); }
        asm volatile("s_waitcnt vmcnt(0) lgkmcnt(0)" ::: "memory"); __builtin_amdgcn_s_barrier(); asm volatile("" ::: "memory");
#pragma unroll
        for (int ai = 0; ai < 2; ++ai)
#pragma unroll
            for (int m = 0; m < 4; ++m) { const int rl = ai * 128 + wr * 64 + m * 16 + fr; const float rs = X[1024 + rl]; const size_t row = (size_t)u.pm * 256 + rl;
                const float* md = mod1 + (row >> 12) * 3072;
#pragma unroll
                for (int bj = 0; bj < 2; ++bj)
#pragma unroll
                    for (int n = 0; n < 2; ++n) { const int col = col0 + bj * 128 + n * 16;
                        const f32x4 gv = *(const f32x4*)(gno + col), sh = *(const f32x4*)(md + col), sc = *(const f32x4*)(md + 1024 + col);
                        const f32x4 hv = acc[ai][bj][m][n] * rs * gv * (sc + 1.0f) + sh;
                        u32x2 w; w.x = pk2(hv.x, hv.y); w.y = pk2(hv.z, hv.w); *(u32x2*)(H + row * DM + col) = w; }
                asm volatile("" ::: "memory"); }
        asm volatile("s_waitcnt lgkmcnt(0)" ::: "memory"); __builtin_amdgcn_s_barrier(); asm volatile("" ::: "memory");
    }
};
DI void phase_out_mid(const Params& p, LAS unsigned char* lds) {
    const int tid = ltid(), wid = tid >> 6;
    const bf16_t* Y = (const bf16_t*)(p.ws + WS_Y); const bf16_t* W = (const bf16_t*)(p.ws + WS_WOUTE);
    bf16_t* XB = (bf16_t*)(p.ws + WS_X1); bf16_t* H = (bf16_t*)(p.ws + WS_H);
    const float* mod0 = (const float*)(p.ws + WS_MOD); const float* mod1 = mod0 + (size_t)36 * 3072;
    float* slots = (float*)(p.ws + WS_XSLOT + 512 * 1024); unsigned* cnt = (unsigned*)(p.ws + WS_BAR) + XCNT_WORD + 80;
    pg8::Gemm g{Y, W, 2048, 2048, 2048}; pg8::StaticOrder S; S.init(MP, DM, gridDim.x, blockIdx.x, 2048, 2048);
    EpiMid E{p.in[0], mod0, mod1, p.in[16], XB, H, slots, cnt, (LAS float*)(lds + 131072 + 1024)};
    pg8::gemm_phase<EpiMid, pg8::StaticOrder>(lds, g, S, E);
    LAS float* T = (LAS float*)(lds + 40960); LAS float* Rs = T + 32 * 33;
    const float* xs0 = p.in[1];
    small_gemm(lds, Y + (size_t)MP * 2048, 2048, W, 2048, 2048, DM, blockIdx.x, gridDim.x, [=](int row, int col, float v) {
        const float x1 = xs0[row * DM + col] + mod0[(size_t)(4 + row) * 3072 + 2048 + col] * v;
        T[row * 33 + (col & 31)] = x1; XB[(size_t)(MP + row) * DM + col] = (bf16_t)f2bf(x1); });
    if (blockIdx.x < 32) {
        float* ss_slots = slots + (size_t)MP * 4; const int n0 = blockIdx.x * 32;
        if (tid < 32) { float ss = 0.f;
#pragma unroll 8
            for (int c = 0; c < 32; ++c) { const float t = T[tid * 33 + c]; ss += t * t; }
            __hip_atomic_store(ss_slots + tid * 32 + blockIdx.x, ss, __ATOMIC_RELAXED, __HIP_MEMORY_SCOPE_AGENT); }
        asm volatile("s_waitcnt vmcnt(0)" ::: "memory");
        if (tid == 0) __hip_atomic_fetch_add(cnt + 64, 1u, __ATOMIC_RELAXED, __HIP_MEMORY_SCOPE_AGENT);
        if (wid == 0) { unsigned spins = 0;
            while ((unsigned)__builtin_amdgcn_readfirstlane(__hip_atomic_load(cnt + 64, __ATOMIC_RELAXED, __HIP_MEMORY_SCOPE_AGENT)) < 32u && ++spins < (1u << 22)) __builtin_amdgcn_s_sleep(2);
            __builtin_amdgcn_fence(__ATOMIC_ACQUIRE, "agent"); }
        __syncthreads();
        if (tid < 32) { float tot = 0.f;
            for (int t = 0; t < 32; ++t) tot += __hip_atomic_load(ss_slots + tid * 32 + t, __ATOMIC_RELAXED, __HIP_MEMORY_SCOPE_AGENT);
            Rs[tid] = rsqrtf(tot * (1.0f / DM) + EPS); }
        __syncthreads();
        for (int e = tid; e < 1024; e += NTHREADS) { const int r = e >> 5, col = n0 + (e & 31); const float* md = mod1 + (size_t)(4 + r) * 3072;
            H[(size_t)(MP + r) * DM + col] = (bf16_t)f2bf(T[r * 33 + (e & 31)] * Rs[r] * p.in[16][col] * (md[1024 + col] + 1.0f) + md[col]); }
    }
}

struct RetOrder {
    int G, c, kind;
    DI bool next(int i, pg8::Unit& u) const { const int L = i * G + c; if (L >= 256) return false; u.pm = L; u.pn = 0; return true; }
    DI size_t offA(const pg8::Unit& u) const {
        const int b = u.pm >> 6, h = (u.pm >> 4) & 3, cc = u.pm & 15;
        if (kind == 0) return ((size_t)u.pm * 256 * 512 + 256) * 2;
        return (size_t)u.pm * 256 * 512 * 2;
    }
    DI size_t offB(const pg8::Unit& u) const {
        const int b = u.pm >> 6, h = (u.pm >> 4) & 3, cc = u.pm & 15;
        if (kind == 0) return ((size_t)(h * 256) * MP + (size_t)b * SEQ + cc * 256) * 2;
        if (kind == 1) return (((size_t)b * SEQ + cc * 256) * NIN_O + 3072 + h * 256) * 2;
        return (size_t)u.pm * 256 * 512 * 2;
    }
};

DI float ret_log2g(int h) { return log2f(1.0f - exp2f(-5.0f - (float)h)); }
DI float swap_adj(float v) { return __builtin_bit_cast(float, __builtin_amdgcn_update_dpp(0, __builtin_bit_cast(int, v), 0xB1, 0xF, 0xF, true)); }
struct EpiInO {
    static constexpr bool PERM = true;
    bf16_t* Z1; bf16_t* KTD; bf16_t* AQP; bf16_t* BSV;
    DI void operator()(const f32x4 (&acc)[2][2][4][2], const pg8::Unit& u, int wr, int wc, int fr, int fq) const {
        const int row0 = u.pm * 256 + wr * 64 + fr, colt = u.pn * 256 + wc * 32 + 8 * fq;
        const int region = u.pn >> 2, h = u.pn & 3;
        const float lg = ret_log2g(h);
#pragma unroll
        for (int ai = 0; ai < 2; ++ai)
#pragma unroll
            for (int m = 0; m < 4; ++m) { const int row = row0 + ai * 128 + m * 16; const int i = row & 255;
                const size_t ru = ((size_t)(((row >> 12) * 4 + h) * 16 + ((row >> 8) & 15))) * 256;
#pragma unroll
                for (int bj = 0; bj < 2; ++bj) { f32x4 v0 = acc[ai][bj][m][0], v1 = acc[ai][bj][m][1]; const int col = colt + bj * 128;
                    if (region == 2) {
                        const float gq = exp2f((float)(i + 1) * lg);
                        u32x4 w; w.x = pg8::cvt_pk_bf16(v0[0] * gq, v0[1] * gq); w.y = pg8::cvt_pk_bf16(v0[2] * gq, v0[3] * gq); w.z = pg8::cvt_pk_bf16(v1[0] * gq, v1[1] * gq); w.w = pg8::cvt_pk_bf16(v1[2] * gq, v1[3] * gq);
                        *(u32x4*)(AQP + (ru + i) * 512 + (col & 255)) = w;
                    }
                    if (region == 3) {
                        const float dec = exp2f((float)(255 - i) * lg) * 0.0625f;
                        const float tv[8] = {v0[0] * dec, v0[1] * dec, v0[2] * dec, v0[3] * dec, v1[0] * dec, v1[1] * dec, v1[2] * dec, v1[3] * dec};
                        const bool odd = fr & 1;
                        unsigned* t = (unsigned*)(KTD + (size_t)(col - 3072 + (odd ? 1 : 0)) * MP + (row & ~1));
#pragma unroll
                        for (int k = 0; k < 4; ++k) { const float rc = swap_adj(odd ? tv[2 * k] : tv[2 * k + 1]);
                            t[(size_t)k * MP] = odd ? pk2(rc, tv[2 * k + 1]) : pk2(tv[2 * k], rc); }
                        v0 = v0 * 0.0625f; v1 = v1 * 0.0625f;
                    }
                    if (region == 2) { } else
                    if (region == 4) {
                        const float tv[8] = {v0[0], v0[1], v0[2], v0[3], v1[0], v1[1], v1[2], v1[3]};
                        const bool odd = fr & 1;
                        unsigned* t = (unsigned*)(BSV + (ru + (col & 255) + (odd ? 1 : 0)) * 512 + 256 + (i & ~1));
#pragma unroll
                        for (int k = 0; k < 4; ++k) { const float rc = swap_adj(odd ? tv[2 * k] : tv[2 * k + 1]);
                            t[k * 512] = odd ? pk2(rc, tv[2 * k + 1]) : pk2(tv[2 * k], rc); }
                    } else {
                        if (region == 1 || region == 5) {
#pragma unroll
                            for (int k = 0; k < 4; ++k) { v0[k] = silu(v0[k]); v1[k] = silu(v1[k]); } }
                        u32x4 w; w.x = pg8::cvt_pk_bf16(v0[0], v0[1]); w.y = pg8::cvt_pk_bf16(v0[2], v0[3]); w.z = pg8::cvt_pk_bf16(v1[0], v1[1]); w.w = pg8::cvt_pk_bf16(v1[2], v1[3]);
                        *(u32x4*)(Z1 + (size_t)row * NIN_O + col) = w;
                    }
                    asm volatile("" ::: "memory"); } }
    }
};
DI void phase6(const Params& p, LAS unsigned char* lds) {
    bf16_t* H = (bf16_t*)(p.ws + WS_H); bf16_t* Z1 = (bf16_t*)(p.ws + WS_Z); const bf16_t* W = (const bf16_t*)(p.ws + WS_WINO);
    pg8::Gemm g{H, W, DM, DM, DM}; pg8::StaticOrder S; S.init(MP, NIN_O, gridDim.x, blockIdx.x, DM, DM);
    EpiInO E{Z1, (bf16_t*)(p.ws + WS_KT), (bf16_t*)(p.ws + WS_AQP), (bf16_t*)(p.ws + WS_BSV)};
    pg8::gemm_phase<EpiInO, pg8::StaticOrder>(lds, g, S, E);
    small_gemm(lds, H + (size_t)MP * DM, DM, W, DM, DM, NIN_O, blockIdx.x, gridDim.x, [=](int row, int col, float v) {
        const int rg = col >> 10;
        Z1[(size_t)(MP + row) * NIN_O + col] = (bf16_t)f2bf(rg == 3 ? v * 0.0625f : (rg == 1 || rg == 5) ? silu(v) : v); });
}

struct EpiKV {
    static constexpr bool PERM = true;
    bf16_t* KVC;
    DI void operator()(const f32x4 (&acc)[2][2][4][2], const pg8::Unit& u, int wr, int wc, int fr, int fq) const {
        bf16_t* o = KVC + (size_t)u.pm * 65536 + (size_t)(wr * 64 + fr) * 256 + wc * 32 + 8 * fq;
#pragma unroll
        for (int ai = 0; ai < 2; ++ai)
#pragma unroll
            for (int m = 0; m < 4; ++m)
#pragma unroll
                for (int bj = 0; bj < 2; ++bj) { const f32x4 v0 = acc[ai][bj][m][0], v1 = acc[ai][bj][m][1];
                    u32x4 w; w.x = pk2(v0[0], v0[1]); w.y = pk2(v0[2], v0[3]); w.z = pk2(v1[0], v1[1]); w.w = pk2(v1[2], v1[3]);
                    *(u32x4*)(o + (size_t)(ai * 128 + m * 16) * 256 + bj * 128) = w; }
    }
};
struct EpiScore {
    static constexpr bool PERM = true;
    bf16_t* AQP;
    DI void operator()(const f32x4 (&acc)[2][2][4][2], const pg8::Unit& u, int wr, int wc, int fr, int fq) const {
        const float lg = ret_log2g((u.pm >> 4) & 3);
        int j0 = wc * 32 + 8 * fq; asm volatile("" : "+v"(j0));
        float gj[2][8];
#pragma unroll
        for (int bj = 0; bj < 2; ++bj)
#pragma unroll
            for (int k = 0; k < 8; ++k) gj[bj][k] = exp2f(-(float)(j0 + bj * 128 + k + 1) * lg);
#pragma unroll
        for (int ai = 0; ai < 2; ++ai)
#pragma unroll
            for (int m = 0; m < 4; ++m) { const int i = ai * 128 + wr * 64 + m * 16 + fr;
#pragma unroll
                for (int bj = 0; bj < 2; ++bj) { const int j = j0 + bj * 128; const f32x4 v0 = acc[ai][bj][m][0], v1 = acc[ai][bj][m][1];
                    float y[8];
#pragma unroll
                    for (int k = 0; k < 8; ++k) { const float a = k < 4 ? v0[k & 3] : v1[k & 3]; y[k] = (i - j - k) >= 0 ? a * gj[bj][k] : 0.f; }
                    *(u32x4*)(AQP + ((size_t)u.pm * 256 + i) * 512 + 256 + j) = pack8(y); }
                asm volatile("" ::: "memory"); }
    }
};
template <int W> DI void pooled_run(const Params& p, int run, int gi, int cl) {
    const int row0 = run * 8, tl0 = row0 & (SEQ - 1), b = row0 >> 12, ch = gi * 256 + cl * 8;
    const bf16_t* Z1 = (const bf16_t*)(p.ws + WS_Z); bf16_t* PO = (bf16_t*)(p.ws + WS_POOLED);
    u32x4 rw[W + 7];
#pragma unroll
    for (int i = 0; i < W + 7; ++i) { const int tl = tl0 - (W - 1) + i; rw[i] = (u32x4){0u, 0u, 0u, 0u};
        if (tl >= 0) rw[i] = *(const u32x4*)(Z1 + (size_t)(row0 - (W - 1) + i) * NIN_O + ch); }
    float S[8];
#pragma unroll
    for (int k = 0; k < 8; ++k) S[k] = 0.f;
#pragma unroll
    for (int i = 0; i < W - 1; ++i) { float t[8]; unpack8(rw[i], t);
#pragma unroll
        for (int k = 0; k < 8; ++k) S[k] += t[k]; }
#pragma unroll
    for (int t = 0; t < 8; ++t) {
        const int tl = tl0 + t; float uv[8], y[8], od[8]; unpack8(rw[W - 1 + t], uv); unpack8(rw[t], od);
        const float rc = 1.0f / (float)min(W, tl + 1);
#pragma unroll
        for (int k = 0; k < 8; ++k) { S[k] += uv[k]; y[k] = S[k] * rc - uv[k]; S[k] -= od[k]; }
        *(u32x4*)(PO + (size_t)(row0 + t) * DM + ch) = pack8(y);
        if (tl >= SEQ - 15) { float* o = p.out + O_POOLP + (size_t)(b * 15 + (tl - (SEQ - 15))) * 1024 + ch; *(f32x4*)o = (f32x4){uv[0], uv[1], uv[2], uv[3]}; *(f32x4*)(o + 4) = (f32x4){uv[4], uv[5], uv[6], uv[7]}; }
    }
}
DI void phase7(const Params& p, LAS unsigned char* lds) {
    const int tid = ltid(), wid = tid >> 6, lane = tid & 63, G = gridDim.x;
    const int gw = blockIdx.x * NWAVES + wid, NGW = G * NWAVES;
    {
        pg8::Gemm g{(const bf16_t*)(p.ws + WS_BSV), (const bf16_t*)(p.ws + WS_KT), 512, MP, 256}; RetOrder S{G, (int)blockIdx.x, 0};
        EpiKV E{(bf16_t*)(p.ws + WS_KVC)};
        SUB(70, pg8::gemm_phase<EpiKV, RetOrder>(lds, g, S, E));
    }
    {
        pg8::Gemm g{(const bf16_t*)(p.ws + WS_AQP), (const bf16_t*)(p.ws + WS_Z), 512, NIN_O, 256}; RetOrder S{G, (int)blockIdx.x, 1};
        EpiScore E{(bf16_t*)(p.ws + WS_AQP)};
        SUB(71, pg8::gemm_phase<EpiScore, RetOrder>(lds, g, S, E));
    }
    SUB(72, for (int it = gw; it < 4096; it += NGW) {
        const int gi = it & 3, run = (it >> 2) * 2 + (lane >> 5), cl = lane & 31;
        if (gi == 0) pooled_run<2>(p, run, 0, cl); else if (gi == 1) pooled_run<4>(p, run, 1, cl); else if (gi == 2) pooled_run<8>(p, run, 2, cl); else pooled_run<16>(p, run, 3, cl);
    });
    for (int it = blockIdx.x * NTHREADS + tid; it < NS * 256; it += G * NTHREADS) {
        const int b = it >> 8, ch = (it & 255) * 4, w = 2 << (ch >> 8);
        const u32x2 uw = *(const u32x2*)((const bf16_t*)(p.ws + WS_Z) + (size_t)(MP + b) * NIN_O + ch);
        const f32x4 u0 = (f32x4){bflo(uw.x), bfhi(uw.x), bflo(uw.y), bfhi(uw.y)};
        const float* prev = p.in[7] + (size_t)(b * 15) * 1024 + ch; float* po = p.out + O_POOLS + (size_t)(b * 15) * 1024 + ch;
        f32x4 pr[15];
#pragma unroll
        for (int j = 0; j < 15; ++j) pr[j] = *(const f32x4*)(prev + (size_t)j * 1024);
        f32x4 s = u0;
#pragma unroll
        for (int i = 1; i < 16; ++i) if (i < w) s += pr[15 - i];
        const f32x4 y = s * (1.0f / (float)w) - u0;
        u32x2 o; o.x = pk2(y.x, y.y); o.y = pk2(y.z, y.w);
        *(u32x2*)((bf16_t*)(p.ws + WS_POOLED) + (size_t)(MP + b) * DM + ch) = o;
#pragma unroll
        for (int j = 0; j < 14; ++j) *(f32x4*)(po + (size_t)j * 1024) = pr[j + 1];
        *(f32x4*)(po + (size_t)14 * 1024) = u0;
    }
}

DI void ret_sample_item(const Params& p, LAS unsigned char* ldsb, int item);
struct EpiPool {
    static constexpr bool PERM = true;
    const bf16_t* Z1; bf16_t* Y; const float* ps;
    DI void operator()(const f32x4 (&acc)[2][2][4][2], const pg8::Unit& u, int wr, int wc, int fr, int fq) const {
        const int row0 = u.pm * 256 + wr * 64 + fr, colt = u.pn * 256 + wc * 32 + 8 * fq;
#pragma unroll
        for (int ai = 0; ai < 2; ++ai)
#pragma unroll
            for (int m = 0; m < 4; ++m) { const size_t row = row0 + ai * 128 + m * 16;
#pragma unroll
                for (int bj = 0; bj < 2; ++bj) { const int col = colt + bj * 128; const f32x4 v0 = acc[ai][bj][m][0], v1 = acc[ai][bj][m][1];
                    float gc[8]; unpack8(__builtin_nontemporal_load((const u32x4*)(Z1 + row * NIN_O + 1024 + col)), gc);
                    const f32x4 s0 = *(const f32x4*)(ps + col), s1 = *(const f32x4*)(ps + col + 4);
                    float y[8];
#pragma unroll
                    for (int k = 0; k < 4; ++k) { y[k] = v0[k] * s0[k] * gc[k]; y[4 + k] = v1[k] * s1[k] * gc[4 + k]; }
                    *(u32x4*)(Y + row * 2048 + col) = pack8(y); }
                asm volatile("" ::: "memory"); }
    }
};
DI void phase8(const Params& p, LAS unsigned char* lds) {
    const int tid = ltid(), G = gridDim.x;
    const bf16_t* Z1 = (const bf16_t*)(p.ws + WS_Z); bf16_t* Y = (bf16_t*)(p.ws + WS_Y); const bf16_t* PO = (const bf16_t*)(p.ws + WS_POOLED); const bf16_t* PW = (const bf16_t*)(p.ws + WS_PWT);
    {
        pg8::Gemm g{PO, PW, DM, 256, 256}; pg8::StaticOrder S; S.init(MP, DM, G, blockIdx.x, DM, 256, 512);
        EpiPool E{Z1, Y, p.in[21]};
        pg8::gemm_phase<EpiPool, pg8::StaticOrder>(lds, g, S, E);
    }
    const float* ps = p.in[21];
    for (int gi = 0; gi < 4; ++gi)
        small_gemm(lds, PO + (size_t)MP * DM + gi * 256, DM, PW + (size_t)gi * 65536, 256, 256, 256, ((int)blockIdx.x + G - 8 * gi) % G, G, [=](int row, int col, float v) {
            const int cc = gi * 256 + col; const float gc = bf2f(Z1[(size_t)(MP + row) * NIN_O + 1024 + cc]);
            Y[(size_t)(MP + row) * 2048 + cc] = (bf16_t)f2bf(v * ps[cc] * gc); });
    for (int it = G - 1 - (int)blockIdx.x; it < 128; it += G) ret_sample_item(p, lds, it);
    const bf16_t* KVC = (const bf16_t*)(p.ws + WS_KVC); bf16_t* BSV = (bf16_t*)(p.ws + WS_BSV);
    for (int it = blockIdx.x * NTHREADS + tid; it < 16 * 8192; it += G * NTHREADS) {
        const int bh = it >> 13, e = (it & 8191) * 8, dv = e >> 8, dk0 = e & 255;
        const float g256 = exp2f(256.0f * ret_log2g(bh & 3));
        float s[8];
#pragma unroll
        for (int k = 0; k < 8; ++k) s[k] = 0.f;
#pragma unroll
        for (int c = 0; c < 16; ++c) {
            const size_t u = (size_t)(bh * 16 + c);
            float kv[8]; unpack8(__builtin_nontemporal_load((const u32x4*)(KVC + u * 65536 + e)), kv);
            *(u32x4*)(BSV + (u * 256 + dv) * 512 + dk0) = pack8(s);
#pragma unroll
            for (int k = 0; k < 8; ++k) s[k] = g256 * s[k] + kv[k];
        }
        float* o = p.out + O_RETP + (size_t)bh * 65536 + (size_t)dk0 * 256 + dv;
#pragma unroll
        for (int k = 0; k < 8; ++k) __builtin_nontemporal_store(s[k], o + (size_t)k * 256);
    }
}

struct EpiRet {
    static constexpr bool PERM = true;
    const bf16_t* Z1; bf16_t* Y; LAS float* X;
    DI void operator()(const f32x4 (&acc)[2][2][4][2], const pg8::Unit& u, int wr, int wc, int fr, int fq) const {
        const int b = u.pm >> 6, h = (u.pm >> 4) & 3, cc = u.pm & 15;
#pragma unroll
        for (int ai = 0; ai < 2; ++ai)
#pragma unroll
            for (int m = 0; m < 4; ++m) { float ss = 0.f;
#pragma unroll
                for (int bj = 0; bj < 2; ++bj)
#pragma unroll
                    for (int n = 0; n < 2; ++n) { const f32x4 v = acc[ai][bj][m][n]; ss += (v[0] * v[0] + v[1] * v[1]) + (v[2] * v[2] + v[3] * v[3]); }
                ss += __shfl_xor(ss, 16); ss += __shfl_xor(ss, 32);
                if (fq == 0) X[(ai * 128 + wr * 64 + m * 16 + fr) * 4 + wc] = ss; }
        asm volatile("s_waitcnt lgkmcnt(0)" ::: "memory"); __builtin_amdgcn_s_barrier(); asm volatile("" ::: "memory");
        const size_t rowbase = (size_t)b * SEQ + cc * 256;
#pragma unroll
        for (int ai = 0; ai < 2; ++ai)
#pragma unroll
            for (int m = 0; m < 4; ++m) { const int i = ai * 128 + wr * 64 + m * 16 + fr;
                const f32x4 xs = *(const LAS f32x4*)(X + i * 4);
                const float rstd = rsqrtf(((xs[0] + xs[1]) + (xs[2] + xs[3])) * (1.0f / 256.0f) + EPS);
#pragma unroll
                for (int bj = 0; bj < 2; ++bj) { const int col = wc * 32 + 8 * fq + bj * 128; const f32x4 v0 = acc[ai][bj][m][0], v1 = acc[ai][bj][m][1];
                    float gd[8], y[8]; unpack8(__builtin_nontemporal_load((const u32x4*)(Z1 + (rowbase + i) * NIN_O + 5120 + h * 256 + col)), gd);
#pragma unroll
                    for (int k = 0; k < 4; ++k) { y[k] = v0[k] * rstd * gd[k]; y[4 + k] = v1[k] * rstd * gd[4 + k]; }
                    *(u32x4*)(Y + (rowbase + i) * 2048 + 1024 + h * 256 + col) = pack8(y); }
                asm volatile("" ::: "memory"); }
        asm volatile("s_waitcnt lgkmcnt(0)" ::: "memory"); __builtin_amdgcn_s_barrier(); asm volatile("" ::: "memory");
    }
};
DI void ret_sample_item(const Params& p, LAS unsigned char* ldsb, int item) {
    const int tid = ltid(), wid = tid >> 6, lane = tid & 63;
    const int b = item >> 2, h = item & 3;
    LAS float* qs = (LAS float*)ldsb; LAS float* ks = qs + 256; LAS float* vs = qs + 512; LAS float* red = qs + 768; LAS float* misc = qs + 768 + 2048;
    const bf16_t* zr = (const bf16_t*)(p.ws + WS_Z) + (size_t)(MP + b) * NIN_O;
    if (tid < 256) { qs[tid] = bf2f(zr[2048 + h * 256 + tid]); ks[tid] = bf2f(zr[3072 + h * 256 + tid]); vs[tid] = bf2f(zr[4096 + h * 256 + tid]); }
    __syncthreads();
    float sp = 0.f;
#pragma unroll
    for (int i = 0; i < 4; ++i) sp += qs[lane + 64 * i] * ks[lane + 64 * i];
    const float score = wave_sum(sp);
    const float g = 1.0f - exp2f(-5.0f - (float)h);
    const float* sin = p.in[8] + (size_t)(b * 4 + h) * 65536; float* sout = p.out + O_RETS + (size_t)(b * 4 + h) * 65536;
    const int dv4 = lane * 4;
    const f32x4 v4 = *(const LAS f32x4*)(vs + dv4);
    f32x4 cr = (f32x4){0.f, 0.f, 0.f, 0.f};
#pragma unroll 8
    for (int i = 0; i < 32; ++i) { const int dk = wid + 8 * i; const f32x4 s4 = __builtin_nontemporal_load((const f32x4*)(sin + (size_t)dk * 256 + dv4));
        cr += s4 * qs[dk]; __builtin_nontemporal_store(s4 * g + v4 * ks[dk], (f32x4*)(sout + (size_t)dk * 256 + dv4)); }
    *(LAS f32x4*)(red + wid * 256 + dv4) = cr;
    __syncthreads();
    float o = 0.f;
    if (tid < 256) { float cs = 0.f;
#pragma unroll
        for (int w = 0; w < 8; ++w) cs += red[w * 256 + tid];
        o = score * vs[tid] + cs * g; }
    const float ssw = wave_sum(o * o);
    if (lane == 0) misc[wid] = ssw;
    __syncthreads();
    if (tid < 256) { const float ss = misc[0] + misc[1] + misc[2] + misc[3]; const float rstd = rsqrtf(ss * (1.0f / 256.0f) + EPS);
        const float gd = bf2f(zr[5120 + h * 256 + tid]);
        ((bf16_t*)(p.ws + WS_Y))[(size_t)(MP + b) * 2048 + 1024 + h * 256 + tid] = (bf16_t)f2bf(o * rstd * gd); }
    __syncthreads();
}
DI void phase9(const Params& p, LAS unsigned char* lds) {
    const int G = gridDim.x;
    {
        pg8::Gemm g{(const bf16_t*)(p.ws + WS_AQP), (const bf16_t*)(p.ws + WS_BSV), 512, 512, 512}; RetOrder S{G, (int)blockIdx.x, 2};
        EpiRet E{(const bf16_t*)(p.ws + WS_Z), (bf16_t*)(p.ws + WS_Y), (LAS float*)(lds + 131072 + 1024)};
        pg8::gemm_phase<EpiRet, RetOrder>(lds, g, S, E);
    }
}

DI void final_norm(const Params& p) {
    const int tid = ltid(), wid = tid >> 6, lane = tid & 63, G = gridDim.x;
    const int gw = blockIdx.x * NWAVES + wid, NGW = G * NWAVES;
    const bf16_t* X = (const bf16_t*)(p.ws + WS_X1); const float* gn = p.in[23];
    for (int m0 = gw * 2; m0 < MT; m0 += NGW * 2) {
        f32x4 v[2][4]; float ss[2];
#pragma unroll
        for (int rr = 0; rr < 2; ++rr) { const bf16_t* xrow = X + (size_t)(m0 + rr) * DM; ss[rr] = 0.f;
#pragma unroll
            for (int j = 0; j < 4; ++j) v[rr][j] = ld4bf(xrow + 4 * lane + 256 * j); }
#pragma unroll
        for (int rr = 0; rr < 2; ++rr) {
#pragma unroll
            for (int j = 0; j < 4; ++j) ss[rr] += (v[rr][j].x * v[rr][j].x + v[rr][j].y * v[rr][j].y) + (v[rr][j].z * v[rr][j].z + v[rr][j].w * v[rr][j].w); }
#pragma unroll
        for (int rr = 0; rr < 2; ++rr) { const int m = m0 + rr; float* orow = m < MP ? p.out + O_YP + (size_t)m * DM : p.out + O_YS + (size_t)(m - MP) * DM;
            const float rstd = rsqrtf(wave_sum(ss[rr]) * (1.f / DM) + EPS);
#pragma unroll
            for (int j = 0; j < 4; ++j) { const int col = 4 * lane + 256 * j; __builtin_nontemporal_store(v[rr][j] * rstd * *(const f32x4*)(gn + col), (f32x4*)(orow + col)); } }
    }
}

#define XB_TMO      128
#define XB_XCNT(j)  (256  + 64 * (j))
#define XB_XSUB(j)  (1280 + 64 * (j))
#define XB_XGEN(j)  (2304 + 64 * (j))
#define XB_TOP      3328
#define XB_TOPGEN   3392
#define XCD_BAR_WORDS 3456
#define XB_SPIN_CAP (1u << 22)
DI unsigned xb_ld(unsigned* p)              { return __hip_atomic_load(p, __ATOMIC_RELAXED, __HIP_MEMORY_SCOPE_AGENT); }
DI unsigned xb_add(unsigned* p, unsigned v) { return __hip_atomic_fetch_add(p, v, __ATOMIC_RELAXED, __HIP_MEMORY_SCOPE_AGENT); }
DI unsigned xb_xcc_id() { return (unsigned)__builtin_amdgcn_s_getreg((3 << 11) | 20) & 0xFu; }
#define XB_SPIN(cond, bar) do { unsigned _sp = 0; while (cond) { __builtin_amdgcn_s_sleep(1); \
    if ((++_sp & 255u) == 0u) { if (xb_ld(&(bar)[XB_TMO])) break; if (_sp > XB_SPIN_CAP) { atomicAdd(&(bar)[XB_TMO], 1u); break; } } } } while (0)
struct XcdBarrier { unsigned* bar; unsigned x; volatile LAS unsigned* st; };
DI XcdBarrier xcd_barrier_post(unsigned* bar, volatile LAS unsigned* st) {
    XcdBarrier b; b.bar = bar; b.x = xb_xcc_id(); b.st = st;
    if (threadIdx.x == 0) (void)xb_add(&bar[XB_XCNT(b.x)], 1u);
    return b;
}
DI void xcd_barrier_complete(unsigned* bar, unsigned x, unsigned& nloc, unsigned& nx) {
    const unsigned G = gridDim.x * gridDim.y * gridDim.z;
    unsigned sum, cnt, mine, sp = 0u;
    for (;;) {
        sum = 0u; cnt = 0u; mine = 0u;
#pragma unroll
        for (unsigned j = 0; j < 16; ++j) { const unsigned c = xb_ld(&bar[XB_XCNT(j)]); sum += c; cnt += (c > 0u) ? 1u : 0u; mine = (j == x) ? c : mine; }
        if (sum == G) break;
        __builtin_amdgcn_s_sleep(1);
        if ((++sp & 255u) == 0u) { if (xb_ld(&bar[XB_TMO])) break; if (sp > XB_SPIN_CAP) { atomicAdd(&bar[XB_TMO], 1u); break; } }
    }
    nloc = mine > 0u ? mine : 1u; nx = cnt > 0u ? cnt : 1u;
}
DI void xcd_barrier(const XcdBarrier& b) {
    asm volatile("s_waitcnt vmcnt(0)" ::: "memory");
    __syncthreads();
    if (threadIdx.x == 0) {
        unsigned* bar = b.bar;
        __builtin_amdgcn_s_waitcnt(0);
        unsigned nloc = b.st[0], nx = b.st[1];
        if (nloc == 0u) { xcd_barrier_complete(bar, b.x, nloc, nx); b.st[0] = nloc; b.st[1] = nx; }
        const unsigned old = xb_add(&bar[XB_XSUB(b.x)], 1u);
        const unsigned gen = old / nloc;
        if (old + 1u == (gen + 1u) * nloc) {
            __builtin_amdgcn_fence(__ATOMIC_RELEASE, "agent");
            asm volatile("s_waitcnt vmcnt(0)" ::: "memory");
            const unsigned og = xb_add(&bar[XB_TOP], 1u);
            const unsigned tg = og / nx;
            if (og + 1u == (tg + 1u) * nx) xb_add(&bar[XB_TOPGEN], 1u);
            else XB_SPIN(xb_ld(&bar[XB_TOPGEN]) == tg, bar);
            __builtin_amdgcn_fence(__ATOMIC_ACQUIRE, "agent");
            xb_add(&bar[XB_XGEN(b.x)], 1u);
            asm volatile("s_waitcnt vmcnt(0)" ::: "memory");
        } else {
            XB_SPIN(xb_ld(&bar[XB_XGEN(b.x)]) == gen, bar);
            __builtin_amdgcn_fence(__ATOMIC_ACQUIRE, "agent");
            asm volatile("s_waitcnt vmcnt(0)" ::: "memory");
        }
    }
    __syncthreads();
}

#ifndef ONLYP
#define ONLYP -1
#endif
#ifndef SKIPP
#define SKIPP -2
#endif
#define PH(k) ((ONLYP < 0 || ONLYP == (k)) && SKIPP != (k))
#ifndef REPP
#define REPP -3
#endif

#ifndef REPQ
#define REPQ -3
#endif
#define RP(k, call) do { if (PH(k)) { call; if (REPP == (k) || REPQ == (k)) { GSYNC(); call; } } } while (0)
__global__ void __launch_bounds__(NTHREADS, 2) fwd_megakernel(Params p) {
    extern __shared__ __attribute__((aligned(16))) unsigned char lds_raw[];
    LAS unsigned char* lds = (LAS unsigned char*)lds_raw;
    cg::grid_group grid = cg::this_grid();
    volatile LAS unsigned* bst = (volatile LAS unsigned*)(lds + LDS_BYTES - 16);
    if (threadIdx.x < 2) bst[threadIdx.x] = 0u;
    __syncthreads();
    const XcdBarrier xbar = xcd_barrier_post((unsigned*)(p.ws + WS_BAR), bst);
#define GSYNC() xcd_barrier(xbar)
    if (p.ws == nullptr) grid.sync();
    RP(0, phase0(p, lds));
    GSYNC();
    RP(1, h_rows<false>(p, 0, p.in[0], p.in[1]));
    GSYNC();
    RP(2, phase2(p, lds));
    GSYNC();
    RP(3, phase3(p, lds));
    GSYNC();
    if (gridDim.x == 256) { if (PH(4)) phase_out_mid(p, lds); GSYNC(); }
    else { RP(4, phase_out(p, lds, 0)); GSYNC(); RP(5, h_rows<true>(p, 1, (const bf16_t*)(p.ws + WS_X1), (const bf16_t*)(p.ws + WS_X1) + (size_t)MP * DM)); GSYNC(); }
    RP(6, phase6(p, lds));
    GSYNC();
    RP(7, phase7(p, lds));
    GSYNC();
    RP(8, phase8(p, lds));
    GSYNC();
    RP(9, phase9(p, lds));
    GSYNC();
    if (gridDim.x == 256) { if (PH(10)) phase_out_final(p, lds); }
    else { RP(10, phase_out(p, lds, 1)); GSYNC(); RP(11, final_norm(p)); }
}

extern "C" void kernel_launch(void* const* d_in, const int* in_sizes, int n_in, void* d_out, int out_size, void* d_ws, size_t ws_size, hipStream_t stream) {
    static int grid = 0;
    if (grid == 0) {
        if (n_in != 24 || (size_t)out_size != O_END || ws_size < WS_END) { fprintf(stderr, "kernel_launch: unexpected shapes: n_in %d out %d ws %zu\n", n_in, out_size, ws_size); grid = -1; return; }
        int dev = 0, cus = 0, per_cu = 0;
        if (hipGetDevice(&dev) != hipSuccess || hipDeviceGetAttribute(&cus, hipDeviceAttributeMultiprocessorCount, dev) != hipSuccess) { grid = -1; return; }
        if (hipFuncSetAttribute((const void*)fwd_megakernel, hipFuncAttributeMaxDynamicSharedMemorySize, LDS_BYTES) != hipSuccess) { fprintf(stderr, "kernel_launch: hipFuncSetAttribute failed\n"); grid = -1; return; }
        if (hipOccupancyMaxActiveBlocksPerMultiprocessor(&per_cu, (const void*)fwd_megakernel, NTHREADS, LDS_BYTES) != hipSuccess || per_cu < 1) { fprintf(stderr, "kernel_launch: occupancy query says %d\n", per_cu); per_cu = 1; }
        (void)hipGetLastError();
        grid = cus;
    }
    if (grid < 0) return;
    if (hipMemsetAsync((char*)d_ws + WS_BAR, 0, 16384, stream) != hipSuccess) { fprintf(stderr, "kernel_launch: memset failed\n"); return; }
    Params p{};
    for (int i = 0; i < 24; ++i) p.in[i] = (const float*)d_in[i];
    p.out = (float*)d_out; p.ws = (unsigned char*)d_ws;
    void* args[] = {&p};
    hipError_t e = hipLaunchCooperativeKernel((const void*)fwd_megakernel, dim3(grid), dim3(NTHREADS), args, LDS_BYTES, stream);
    if (e != hipSuccess) fprintf(stderr, "cooperative launch failed: %s (grid %d)\n", hipGetErrorString(e), grid);
}
```
